# Optimizing an MI355X kernel written in HIP

```python
import jax
import jax.numpy as jnp
from jax import lax
import numpy as np

D_MODEL = 1024
BATCH = 8
SEQ = 2048
DEPTH = 4

HEAD_DIM = 64
ATT_HEADS = D_MODEL // 128
ATT_WIDTH = ATT_HEADS * HEAD_DIM
MOBA_BLOCK = 256
MOBA_TOPK = 3
Q_CHUNK = 32
ROPE_THETA = 10000.0
CONF_WIDTH = D_MODEL // 4
CONF_KERNEL = 31
POOL_GROUPS = 4
POOL_WIDTH = D_MODEL // 4
POOL_GW = POOL_WIDTH // POOL_GROUPS
POOL_WINDOWS = (2, 4, 8, 16)
SC_WIDTH = D_MODEL // 4
SC_KERNEL = 3
N_BRANCH = 4
D_FF = 4 * D_MODEL
IN_WIDTHS = (ATT_WIDTH, ATT_WIDTH, ATT_WIDTH, 2 * CONF_WIDTH, POOL_WIDTH,
             SC_WIDTH, SC_WIDTH, SC_WIDTH, N_BRANCH * D_MODEL)
IN_WIDTH = sum(IN_WIDTHS)
SPLIT_POINTS = tuple(int(s) for s in np.cumsum(IN_WIDTHS)[:-1])
DEEPNORM_ALPHA = (2.0 * DEPTH) ** 0.25
DEEPNORM_BETA = (8.0 * DEPTH) ** -0.25
LN_EPS = 1e-5

kernel_name = 'hybrid_gated_moba_conv_pool_shortconv_trunk'


def layer_norm(x, g, b):
    xf = x.astype(jnp.float32)
    mu = jnp.mean(xf, axis=-1, keepdims=True)
    var = jnp.mean(jnp.square(xf - mu), axis=-1, keepdims=True)
    y = (xf - mu) * lax.rsqrt(var + LN_EPS)
    return (y * g.astype(jnp.float32) + b.astype(jnp.float32)).astype(x.dtype)


def rope_tables(T):
    inv = ROPE_THETA ** (-jnp.arange(0, HEAD_DIM, 2, dtype=jnp.float32) / HEAD_DIM)
    ang = jnp.arange(T, dtype=jnp.float32)[:, None] * inv[None, :]
    return jnp.cos(ang), jnp.sin(ang)


def apply_rope(x, cos, sin):
    xf = x.astype(jnp.float32)
    x1, x2 = jnp.split(xf, 2, axis=-1)
    c = cos[None, :, None, :]
    s = sin[None, :, None, :]
    return jnp.concatenate([x1 * c - x2 * s, x2 * c + x1 * s], axis=-1).astype(x.dtype)


def causal_depthwise_conv(u, w):
    K = w.shape[0]
    return lax.conv_general_dilated(
        u, w[:, None, :].astype(u.dtype), window_strides=(1,), padding=[(K - 1, 0)],
        dimension_numbers=('NWC', 'WIO', 'NWC'), feature_group_count=u.shape[-1])


def moba_attention(q, k, v):
    B, T, H, dh = q.shape
    L = MOBA_BLOCK
    nb = -(-T // L)
    tp = nb * L
    pad = ((0, 0), (0, 0), (0, tp - T), (0, 0))
    qh = jnp.pad(q.transpose(0, 2, 1, 3), pad)
    kh = jnp.pad(k.transpose(0, 2, 1, 3), pad)
    vh = jnp.pad(v.transpose(0, 2, 1, 3), pad)
    kb = kh.reshape(B, H, nb, L, dh)
    vb = vh.reshape(B, H, nb, L, dh)
    kbar = jnp.mean(kb.astype(jnp.float32), axis=3)
    qblk = jnp.arange(tp) // L
    gate = jnp.einsum('bhtd,bhnd->bhtn', qh.astype(jnp.float32), kbar)
    past = jnp.arange(nb)[None, :] < qblk[:, None]
    gate = jnp.where(past[None, None], gate, -jnp.inf)
    k_sel = min(MOBA_TOPK, nb)
    _, idx = lax.top_k(gate, k_sel)
    valid = idx < qblk[None, None, :, None]
    nc = tp // Q_CHUNK
    q_c = qh.reshape(B, H, nc, Q_CHUNK, dh).transpose(2, 0, 1, 3, 4)
    idx_c = idx.reshape(B, H, nc, Q_CHUNK, k_sel).transpose(2, 0, 1, 3, 4)
    val_c = valid.reshape(B, H, nc, Q_CHUNK, k_sel).transpose(2, 0, 1, 3, 4)
    starts = jnp.arange(nc, dtype=jnp.int32) * Q_CHUNK
    bi = jnp.arange(B)[:, None, None, None]
    hi = jnp.arange(H)[None, :, None, None]
    scale = dh ** -0.5

    def chunk(args):
        qc, ic, vc, start = args
        ks = kb[bi, hi, ic]
        vs = vb[bi, hi, ic]
        s_past = jnp.einsum('bhqd,bhqnld->bhqnl', qc, ks).astype(jnp.float32) * scale
        s_past = jnp.where(vc[..., None], s_past, -jnp.inf).reshape(B, H, Q_CHUNK, k_sel * L)
        blk = start // L
        ko = lax.dynamic_index_in_dim(kb, blk, axis=2, keepdims=False)
        vo = lax.dynamic_index_in_dim(vb, blk, axis=2, keepdims=False)
        s_own = jnp.einsum('bhqd,bhld->bhql', qc, ko).astype(jnp.float32) * scale
        qpos = start + jnp.arange(Q_CHUNK)
        kpos = blk * L + jnp.arange(L)
        s_own = jnp.where((kpos[None, :] <= qpos[:, None])[None, None], s_own, -jnp.inf)
        p = jax.nn.softmax(jnp.concatenate([s_past, s_own], axis=-1), axis=-1)
        p_past = p[..., :k_sel * L].reshape(B, H, Q_CHUNK, k_sel, L).astype(vs.dtype)
        p_own = p[..., k_sel * L:].astype(vo.dtype)
        return (jnp.einsum('bhqnl,bhqnld->bhqd', p_past, vs)
                + jnp.einsum('bhql,bhld->bhqd', p_own, vo))

    out = lax.map(chunk, (q_c, idx_c, val_c, starts))
    out = out.transpose(1, 0, 3, 2, 4).reshape(B, tp, H, dh)
    return out[:, :T]


def multiscale_pool(u, w_grp, scale):
    B, T, _ = u.shape
    ug = u.reshape(B, T, POOL_GROUPS, POOL_GW).astype(jnp.float32)
    cs = jnp.concatenate([jnp.zeros((B, 1, POOL_GROUPS, POOL_GW), jnp.float32),
                          jnp.cumsum(ug, axis=1)], axis=1)
    win = jnp.array(POOL_WINDOWS, dtype=jnp.int32)
    hi = jnp.arange(T, dtype=jnp.int32) + 1
    lo = jnp.maximum(hi[:, None] - win[None, :], 0)
    gi = jnp.arange(POOL_GROUPS)[None, :]
    window_sum = cs[:, 1:] - cs[:, lo, gi]
    count = (hi[:, None] - lo).astype(jnp.float32)
    d = window_sum / count[None, :, :, None] - ug
    y = jnp.einsum('btgc,gcd->btgd', d, w_grp.astype(jnp.float32)).reshape(B, T, POOL_WIDTH)
    return (y * scale.astype(jnp.float32)).astype(u.dtype)


def setup_inputs(seed: int = 0) -> dict:
    key = jax.random.key(seed)
    ks = jax.random.split(key, 22)
    f32 = jnp.float32

    def nrm(k, shape, s):
        return jax.random.normal(k, shape, f32) * s

    L, D = DEPTH, D_MODEL
    return {
        'x': nrm(ks[0], (BATCH, SEQ, D), 1.0),
        'w_in': nrm(ks[1], (L, D, IN_WIDTH), D ** -0.5),
        'b_in': nrm(ks[2], (L, IN_WIDTH), 0.02),
        'w_dw_conf': nrm(ks[3], (L, CONF_KERNEL, CONF_WIDTH), CONF_KERNEL ** -0.5),
        'b_dw_conf': nrm(ks[4], (L, CONF_WIDTH), 0.02),
        'ln_conf_g': 1.0 + nrm(ks[5], (L, CONF_WIDTH), 0.02),
        'ln_conf_b': nrm(ks[6], (L, CONF_WIDTH), 0.02),
        'w_pool': nrm(ks[7], (L, POOL_GROUPS, POOL_GW, POOL_GW), POOL_GW ** -0.5),
        'pool_scale': 1.0 + nrm(ks[8], (L, POOL_WIDTH), 0.1),
        'w_sc': nrm(ks[9], (L, SC_KERNEL, SC_WIDTH), SC_KERNEL ** -0.5),
        'w_pa': nrm(ks[10], (L, ATT_WIDTH, D), ATT_WIDTH ** -0.5),
        'w_pb': nrm(ks[11], (L, CONF_WIDTH, D), CONF_WIDTH ** -0.5),
        'w_pc': nrm(ks[12], (L, POOL_WIDTH, D), POOL_WIDTH ** -0.5),
        'w_pd': nrm(ks[13], (L, SC_WIDTH, D), SC_WIDTH ** -0.5),
        'w_o': nrm(ks[14], (L, D, D), D ** -0.5 * DEEPNORM_BETA),
        'ln1_g': 1.0 + nrm(ks[15], (L, D), 0.02),
        'ln1_b': nrm(ks[16], (L, D), 0.02),
        'w_mlp1': nrm(ks[17], (L, D, D_FF), D ** -0.5),
        'w_mlp2': nrm(ks[18], (L, D_FF, D), D_FF ** -0.5 * DEEPNORM_BETA),
        'ln2_g': 1.0 + nrm(ks[19], (L, D), 0.02),
        'ln2_b': nrm(ks[20], (L, D), 0.02),
    }


def reference(x, w_in, b_in, w_dw_conf, b_dw_conf, ln_conf_g, ln_conf_b, w_pool,
              pool_scale, w_sc, w_pa, w_pb, w_pc, w_pd, w_o, ln1_g, ln1_b,
              w_mlp1, w_mlp2, ln2_g, ln2_b):
    B, T, _ = x.shape
    cos, sin = rope_tables(T)
    for l in range(DEPTH):
        z = x @ w_in[l] + b_in[l]
        q, k, v, glu, pool_in, sc_x, sc_b, sc_c, gate_logits = jnp.split(z, SPLIT_POINTS, axis=-1)
        q = apply_rope(q.reshape(B, T, ATT_HEADS, HEAD_DIM), cos, sin)
        k = apply_rope(k.reshape(B, T, ATT_HEADS, HEAD_DIM), cos, sin)
        v = v.reshape(B, T, ATT_HEADS, HEAD_DIM)
        y_a = moba_attention(q, k, v).reshape(B, T, ATT_WIDTH)
        a, g = jnp.split(glu, 2, axis=-1)
        u = causal_depthwise_conv(a * jax.nn.sigmoid(g), w_dw_conf[l]) + b_dw_conf[l]
        y_b = jax.nn.silu(layer_norm(u, ln_conf_g[l], ln_conf_b[l]))
        y_c = multiscale_pool(pool_in, w_pool[l], pool_scale[l])
        y_d = sc_b * causal_depthwise_conv(sc_c * sc_x, w_sc[l])
        gates = jax.nn.sigmoid(gate_logits.reshape(B, T, N_BRANCH, D_MODEL))
        mix = (gates[:, :, 0] * (y_a @ w_pa[l]) + gates[:, :, 1] * (y_b @ w_pb[l])
               + gates[:, :, 2] * (y_c @ w_pc[l]) + gates[:, :, 3] * (y_d @ w_pd[l]))
        x = layer_norm(DEEPNORM_ALPHA * x + mix @ w_o[l], ln1_g[l], ln1_b[l])
        h = jnp.square(jax.nn.relu(x @ w_mlp1[l]))
        x = layer_norm(DEEPNORM_ALPHA * x + h @ w_mlp2[l], ln2_g[l], ln2_b[l])
    return x
```

```cpp
#include <hip/hip_runtime.h>
#include <hip/hip_cooperative_groups.h>
#include <cstdio>
#include <cmath>
namespace cg = cooperative_groups;
namespace pg8 {
#define PG8_LAS __attribute__((address_space(3)))
typedef unsigned short bf16_t;
typedef short bf16x8 __attribute__((ext_vector_type(8)));
typedef float f32x4 __attribute__((ext_vector_type(4)));
typedef unsigned u32x4 __attribute__((ext_vector_type(4)));
constexpr int BM = 256, BK = 64, HALF = 128, HTB = HALF * BK * 2  , STAGE_BYTES = 8 * HTB, NXCD = 8, WGM = 8;

__host__ __device__ __forceinline__ int lds_byte(int r, int c) { const int st = (r >> 4) * 2 + (c >> 5), rr = r & 15, cc = c & 31, ob = rr * 64 + cc * 2; return st * 1024 + (ob ^ (((ob >> 9) & 1) << 5)); }
__host__ __device__ __forceinline__ void stage_rc(int b, int& R, int& C) { const int st = b / 1024, sb = b % 1024, swz = sb ^ (((sb >> 9) & 1) << 5); R = (st >> 1) * 16 + swz / 64; C = (st & 1) * 32 + (swz % 64) / 2; }
__host__ __device__ __forceinline__ int perm32(int rho) { const int n = rho >> 4, i = rho & 15; return 8 * (i >> 2) + 4 * n + (i & 3); }

struct Unit { int pm, pn; };
struct Gemm { const bf16_t* A; const bf16_t* Bt; int M, N, K; };

struct StaticOrder {
    int nM, nN, nwg, G, c;
    __host__ __device__ void init(int M, int N, int G_, int c_) { nM = M / BM; nN = N / BM; nwg = nM * nN; G = G_; c = c_; }
    __host__ __device__ bool next(int i, Unit& u) const {
        const long L = (long)i * G + c; if (L >= nwg) return false;
        int wgid = (int)L; { const int q = nwg / NXCD, r = nwg % NXCD, xcd = wgid % NXCD, off = wgid / NXCD; wgid = (xcd < r ? xcd * (q + 1) : r * (q + 1) + (xcd - r) * q) + off; }
        const int nig = WGM * nN, gid = wgid / nig, fm = gid * WGM, gsz = (nM - fm) < WGM ? (nM - fm) : WGM;
        u.pm = fm + ((wgid % nig) % gsz); u.pn = (wgid % nig) / gsz; return true;
    }
    __device__ __forceinline__ void a_ready(const Unit&) const {}
    __device__ __forceinline__ void done(const Unit&) const {}
};
struct CountedOrder : StaticOrder {
    const unsigned* ready; unsigned need; unsigned* tmo;
    __device__ __forceinline__ void a_ready(const Unit& u) const {
        if (threadIdx.x < 64) {
            const unsigned long long t0 = __builtin_amdgcn_s_memrealtime(); unsigned polls = 0;
            while ((unsigned)__builtin_amdgcn_readfirstlane(__hip_atomic_load(ready + 64 * u.pm, __ATOMIC_RELAXED, __HIP_MEMORY_SCOPE_AGENT)) < need) {
                if ((++polls & 255u) == 0u && __builtin_amdgcn_readfirstlane(__hip_atomic_load(tmo, __ATOMIC_RELAXED, __HIP_MEMORY_SCOPE_AGENT)) != 0u) break;
                if (__builtin_amdgcn_s_memrealtime() - t0 > 2000000ull) {
                    if (threadIdx.x == 0) { unsigned expect = 0u; __hip_atomic_compare_exchange_strong(tmo + 1, &expect, 0x600u | (unsigned)(u.pm & 0xff), __ATOMIC_RELAXED, __ATOMIC_RELAXED, __HIP_MEMORY_SCOPE_AGENT); __hip_atomic_store(tmo, 1u, __ATOMIC_RELAXED, __HIP_MEMORY_SCOPE_AGENT); }
                    break; }
                __builtin_amdgcn_s_sleep(2); }
            __builtin_amdgcn_fence(__ATOMIC_ACQUIRE, "agent");
            asm volatile("s_waitcnt vmcnt(0)" ::: "memory");
        }
#if !defined(BROKEN_HOOK_NO_BARRIER)
        asm volatile("" ::: "memory"); __builtin_amdgcn_s_barrier(); asm volatile("" ::: "memory");
#endif
    }
};

__device__ __forceinline__ unsigned cvt_pk_bf16(float lo, float hi) { unsigned r; asm volatile("v_cvt_pk_bf16_f32 %0, %1, %2" : "=v"(r) : "v"(lo), "v"(hi)); return r; }
typedef float f32x2 __attribute__((ext_vector_type(2)));
__device__ __forceinline__ f32x2 gelu_pk(f32x2 v) {
    const f32x2 av = __builtin_elementwise_abs(v), d = av * 0.2316418882f + 1.0f;
    f32x2 t; t.x = __builtin_amdgcn_rcpf(d.x); t.y = __builtin_amdgcn_rcpf(d.y);
    f32x2 q = t * 0.5307027145f + (-0.7265760135f); q = q * t + 0.7107068705f; q = q * t + (-0.142248368f); q = q * t + 0.127414796f; q = q * t;
    const f32x2 s = (v * v) * (-0.72134752044f);
    f32x2 e; e.x = __builtin_amdgcn_exp2f(s.x); e.y = __builtin_amdgcn_exp2f(s.y);
    const f32x2 m = v * (q * e), r = v - m;
    f32x2 o; o.x = v.x < 0.f ? m.x : r.x; o.y = v.y < 0.f ? m.y : r.y; return o;
}

struct EpiF32 {
    static constexpr bool PERM = false, AFTER_DRAIN = false;
    float* C; int ldc; const float* bias;
    __device__ __forceinline__ void operator()(const f32x4 (&acc)[2][2][4][2], const Unit& u, int wr, int wc, int fr, int fq) const {
        const int row0 = u.pm * BM + wr * 64 + fr, col0 = u.pn * BM + wc * 32 + 4 * fq;
        f32x4 bv[2][2];
#pragma unroll
        for (int bj = 0; bj < 2; ++bj)
#pragma unroll
            for (int n = 0; n < 2; ++n) bv[bj][n] = bias ? *(const f32x4*)(bias + col0 + bj * HALF + n * 16) : (f32x4){0.f, 0.f, 0.f, 0.f};
#pragma unroll
        for (int ai = 0; ai < 2; ++ai)
#pragma unroll
            for (int m = 0; m < 4; ++m) { float* rowp = C + (size_t)(row0 + ai * HALF + m * 16) * ldc + col0;
#pragma unroll
                for (int bj = 0; bj < 2; ++bj)
#pragma unroll
                    for (int n = 0; n < 2; ++n) *(f32x4*)(rowp + bj * HALF + n * 16) = acc[ai][bj][m][n] + bv[bj][n]; }
    }
};
template <int ACT  > struct EpiBf16 {
    static constexpr bool PERM = true, AFTER_DRAIN = false;
    bf16_t* O; int ldc; const float* bias; int split_cols; size_t split_stride;
    __device__ __forceinline__ void operator()(const f32x4 (&acc)[2][2][4][2], const Unit& u, int wr, int wc, int fr, int fq) const {
        const int row0 = u.pm * BM + wr * 64 + fr; int colt = u.pn * BM; bf16_t* base = O;
        if (split_cols) { const int t = colt / split_cols; base += (size_t)t * split_stride; colt -= t * split_cols; }
        const int col0 = colt + wc * 32 + 8 * fq, bcol0 = u.pn * BM + wc * 32 + 8 * fq;
        f32x4 bv[2][2];
#pragma unroll
        for (int bj = 0; bj < 2; ++bj)
#pragma unroll
            for (int n = 0; n < 2; ++n) bv[bj][n] = bias ? *(const f32x4*)(bias + bcol0 + bj * HALF + 4 * n) : (f32x4){0.f, 0.f, 0.f, 0.f};
#pragma unroll
        for (int ai = 0; ai < 2; ++ai)
#pragma unroll
            for (int m = 0; m < 4; ++m) { bf16_t* rowp = base + (size_t)(row0 + ai * HALF + m * 16) * ldc + col0;
#pragma unroll
                for (int bj = 0; bj < 2; ++bj) { f32x4 v0 = acc[ai][bj][m][0] + bv[bj][0], v1 = acc[ai][bj][m][1] + bv[bj][1];
                    if (ACT == 1) { f32x2 a = gelu_pk((f32x2){v0[0], v0[1]}), b = gelu_pk((f32x2){v0[2], v0[3]}), c = gelu_pk((f32x2){v1[0], v1[1]}), d = gelu_pk((f32x2){v1[2], v1[3]});
                        v0 = (f32x4){a.x, a.y, b.x, b.y}; v1 = (f32x4){c.x, c.y, d.x, d.y}; }
                    if (ACT == 2) {
#pragma unroll
                        for (int j = 0; j < 4; ++j) { v0[j] = 0.5f * v0[j] * (1.0f + erff(v0[j] * 0.70710678f)); v1[j] = 0.5f * v1[j] * (1.0f + erff(v1[j] * 0.70710678f)); } }
                    u32x4 w; w.x = cvt_pk_bf16(v0[0], v0[1]); w.y = cvt_pk_bf16(v0[2], v0[3]); w.z = cvt_pk_bf16(v1[0], v1[1]); w.w = cvt_pk_bf16(v1[2], v1[3]);
                    *(u32x4*)(rowp + bj * HALF) = w; } }
    }
};

struct PanelStats {
    unsigned* xbuf;
    unsigned* cnt;
    unsigned* tmo;
    int ntn; float eps;
    unsigned code;
    __device__ __forceinline__ bool run(const f32x4 (&v)[2][2][4][2], const Unit& u, int wr, int wc, int fr, int fq, PG8_LAS unsigned char* lds, int wid, int lane) const {
        typedef float f32x2v __attribute__((ext_vector_type(2)));
        PG8_LAS f32x2v* P = (PG8_LAS f32x2v*)lds;
        PG8_LAS f32x2v* S = (PG8_LAS f32x2v*)(lds + 8192);
        PG8_LAS unsigned* flag = (PG8_LAS unsigned*)(lds + 8192 + 2048);
#pragma unroll
        for (int ai = 0; ai < 2; ++ai)
#pragma unroll
            for (int m = 0; m < 4; ++m) {
                float s = 0.f;
#pragma unroll
                for (int bj = 0; bj < 2; ++bj)
#pragma unroll
                    for (int n = 0; n < 2; ++n) { const f32x4 x = v[ai][bj][m][n]; s += (x[0] + x[1]) + (x[2] + x[3]); }
                s += __shfl_xor(s, 16); s += __shfl_xor(s, 32);
                const float mw = s * (1.0f / 64.0f); float q = 0.f;
#pragma unroll
                for (int bj = 0; bj < 2; ++bj)
#pragma unroll
                    for (int n = 0; n < 2; ++n) { const f32x4 d = v[ai][bj][m][n] - mw; q += (d[0] * d[0] + d[1] * d[1]) + (d[2] * d[2] + d[3] * d[3]); }
                q += __shfl_xor(q, 16); q += __shfl_xor(q, 32);
                if (fq == 0) P[(ai * HALF + wr * 64 + m * 16 + fr) * 4 + wc] = (f32x2v){mw, q};
            }
        asm volatile("s_waitcnt lgkmcnt(0)" ::: "memory"); __builtin_amdgcn_s_barrier(); asm volatile("" ::: "memory");
#if defined(BROKEN_NO_WAIT)
        if (blockIdx.x >= 64) { const long long t0 = clock64(); while (clock64() - t0 < 60000) __builtin_amdgcn_s_sleep(8); }
#endif
        const int row = wid * 32 + (lane & 31);
        if (lane < 32) {
            const f32x2v a = P[row * 4 + 0], b = P[row * 4 + 1], c = P[row * 4 + 2], d = P[row * 4 + 3];
            const float mt = (a.x + b.x + c.x + d.x) * 0.25f;
            const float da = a.x - mt, db = b.x - mt, dc = c.x - mt, dd = d.x - mt;
            const float m2 = (a.y + b.y) + (c.y + d.y) + 64.0f * ((da * da + db * db) + (dc * dc + dd * dd));
            unsigned long long* slot = (unsigned long long*)xbuf + ((size_t)(u.pm * BM + row) * 4 + u.pn);
            __hip_atomic_store(slot, ((unsigned long long)__float_as_uint(m2) << 32) | __float_as_uint(mt), __ATOMIC_RELAXED, __HIP_MEMORY_SCOPE_AGENT);
        }
        asm volatile("s_waitcnt vmcnt(0)" ::: "memory");
        if (lane == 0) __hip_atomic_fetch_add(cnt + 64 * u.pm, 1u, __ATOMIC_RELAXED, __HIP_MEMORY_SCOPE_AGENT);
        if (wid == 0) {
            bool dead = false; const unsigned long long t0 = __builtin_amdgcn_s_memrealtime(); const unsigned want = 8u * (unsigned)ntn;
            for (;;) {
#if defined(BROKEN_NO_WAIT)
                break;
#endif
                if ((unsigned)__builtin_amdgcn_readfirstlane(__hip_atomic_load(cnt + 64 * u.pm, __ATOMIC_RELAXED, __HIP_MEMORY_SCOPE_AGENT)) >= want) break;
                if (__builtin_amdgcn_s_memrealtime() - t0 > 2000000ull) {
                    if (lane == 0) { unsigned expect = 0u; __hip_atomic_compare_exchange_strong(tmo + 1, &expect, code | (unsigned)(u.pm & 0xff), __ATOMIC_RELAXED, __ATOMIC_RELAXED, __HIP_MEMORY_SCOPE_AGENT);
                                     __hip_atomic_store(tmo, 1u, __ATOMIC_RELAXED, __HIP_MEMORY_SCOPE_AGENT); }
                    dead = true; break; }
                __builtin_amdgcn_s_sleep(2);
            }
            __builtin_amdgcn_fence(__ATOMIC_ACQUIRE, "agent");
            if (lane == 0) flag[0] = dead ? 1u : 0u;
        }
        asm volatile("s_waitcnt vmcnt(0) lgkmcnt(0)" ::: "memory"); __builtin_amdgcn_s_barrier(); asm volatile("" ::: "memory");
        const bool bad = flag[0] != 0u;
        if (lane < 32) {
            const unsigned long long* slot = (const unsigned long long*)xbuf + (size_t)(u.pm * BM + row) * 4; float mt[4], m2[4]; float ms = 0.f;
#pragma unroll
            for (int t = 0; t < 4; ++t) { if (t < ntn) { const unsigned long long w = __hip_atomic_load(slot + t, __ATOMIC_RELAXED, __HIP_MEMORY_SCOPE_AGENT); mt[t] = __uint_as_float((unsigned)w); m2[t] = __uint_as_float((unsigned)(w >> 32)); } else { mt[t] = 0.f; m2[t] = 0.f; } ms += mt[t]; }
            const float mean = ms / (float)ntn; float q = 0.f;
#pragma unroll
            for (int t = 0; t < 4; ++t) if (t < ntn) { const float dm = mt[t] - mean; q += m2[t] + 256.0f * dm * dm; }
            S[row] = (f32x2v){mean, 1.0f / sqrtf(q / (256.0f * (float)ntn) + eps)};
        }
        asm volatile("s_waitcnt lgkmcnt(0)" ::: "memory"); __builtin_amdgcn_s_barrier(); asm volatile("" ::: "memory");
        return bad;
    }
};
struct EpiLnRes {
    static constexpr bool PERM = false, AFTER_DRAIN = true;
    const float* base; float* out; int ldc; const float* bias; PanelStats st; unsigned poison;
    __device__ __forceinline__ void refuse(size_t i0, size_t stride, int M, int N) const { const float q = __builtin_nanf(""); for (size_t i = i0; i < (size_t)M * N; i += stride) out[(i / N) * ldc + i % N] = q;
        if (i0 == 0) { unsigned expect = 0u; __hip_atomic_compare_exchange_strong(st.tmo + 1, &expect, 0x7f0u, __ATOMIC_RELAXED, __ATOMIC_RELAXED, __HIP_MEMORY_SCOPE_AGENT); __hip_atomic_store(st.tmo, 1u, __ATOMIC_RELAXED, __HIP_MEMORY_SCOPE_AGENT); } }
    __device__ __forceinline__ void fused(f32x4 (&acc)[2][2][4][2], const Unit& u, int wr, int wc, int fr, int fq, PG8_LAS unsigned char* lds, int wid, int lane) const {
        typedef float f32x2v __attribute__((ext_vector_type(2)));
        const PG8_LAS f32x2v* S = (const PG8_LAS f32x2v*)(lds + 8192);
        const int col0 = u.pn * BM + wc * 32 + 4 * fq;
#pragma unroll
        for (int bj = 0; bj < 2; ++bj)
#pragma unroll
            for (int n = 0; n < 2; ++n) { const f32x4 bv = bias ? *(const f32x4*)(bias + col0 + bj * HALF + n * 16) : (f32x4){0.f, 0.f, 0.f, 0.f};
#pragma unroll
                for (int ai = 0; ai < 2; ++ai)
#pragma unroll
                    for (int m = 0; m < 4; ++m) acc[ai][bj][m][n] += bv; }
        const bool bad = st.run(acc, u, wr, wc, fr, fq, lds, wid, lane) || poison != 0u;
        const float qnan = __builtin_nanf("");
#pragma unroll
        for (int ai = 0; ai < 2; ++ai)
#pragma unroll
            for (int m = 0; m < 4; ++m) { const int r = ai * HALF + wr * 64 + m * 16 + fr; const f32x2v sr = S[r]; const size_t off = (size_t)(u.pm * BM + r) * ldc + col0;
#pragma unroll
                for (int bj = 0; bj < 2; ++bj)
#pragma unroll
                    for (int n = 0; n < 2; ++n) { const f32x4 bs = *(const f32x4*)(base + off + bj * HALF + n * 16); f32x4 o = bs + (acc[ai][bj][m][n] - sr.x) * sr.y;
                        if (bad) o = (f32x4){qnan, qnan, qnan, qnan}; *(f32x4*)(out + off + bj * HALF + n * 16) = o; }
                asm volatile("" ::: "memory"); }
    }
};
struct EpiLnResLn {
    static constexpr bool PERM = false, AFTER_DRAIN = true;
    const float* base; float* out; bf16_t* xn; int ldc; const float* bias; PanelStats st1, st2; unsigned poison;
    __device__ __forceinline__ void refuse(size_t i0, size_t stride, int M, int N) const { const float q = __builtin_nanf(""); for (size_t i = i0; i < (size_t)M * N; i += stride) { const size_t o = (i / N) * ldc + i % N; out[o] = q; xn[o] = (bf16_t)0x7fc0u; }
        if (i0 == 0) { unsigned expect = 0u; __hip_atomic_compare_exchange_strong(st1.tmo + 1, &expect, 0x7f0u, __ATOMIC_RELAXED, __ATOMIC_RELAXED, __HIP_MEMORY_SCOPE_AGENT); __hip_atomic_store(st1.tmo, 1u, __ATOMIC_RELAXED, __HIP_MEMORY_SCOPE_AGENT); } }
    __device__ __forceinline__ void fused(f32x4 (&acc)[2][2][4][2], const Unit& u, int wr, int wc, int fr, int fq, PG8_LAS unsigned char* lds, int wid, int lane) const {
        typedef float f32x2v __attribute__((ext_vector_type(2))); typedef unsigned u32x2v __attribute__((ext_vector_type(2)));
        const PG8_LAS f32x2v* S = (const PG8_LAS f32x2v*)(lds + 8192);
        const int col0 = u.pn * BM + wc * 32 + 4 * fq;
#pragma unroll
        for (int bj = 0; bj < 2; ++bj)
#pragma unroll
            for (int n = 0; n < 2; ++n) { const f32x4 bv = bias ? *(const f32x4*)(bias + col0 + bj * HALF + n * 16) : (f32x4){0.f, 0.f, 0.f, 0.f};
#pragma unroll
                for (int ai = 0; ai < 2; ++ai)
#pragma unroll
                    for (int m = 0; m < 4; ++m) acc[ai][bj][m][n] += bv; }
        bool bad = st1.run(acc, u, wr, wc, fr, fq, lds, wid, lane) || poison != 0u;
        const float qnan = __builtin_nanf("");
#pragma unroll
        for (int ai = 0; ai < 2; ++ai)
#pragma unroll
            for (int m = 0; m < 4; ++m) { const int r = ai * HALF + wr * 64 + m * 16 + fr; const f32x2v sr = S[r]; const size_t off = (size_t)(u.pm * BM + r) * ldc + col0;
#pragma unroll
                for (int bj = 0; bj < 2; ++bj)
#pragma unroll
                    for (int n = 0; n < 2; ++n) { const f32x4 bs = *(const f32x4*)(base + off + bj * HALF + n * 16); acc[ai][bj][m][n] = bs + (acc[ai][bj][m][n] - sr.x) * sr.y; }
                asm volatile("" : "+v"(acc[ai][0][m][0]), "+v"(acc[ai][0][m][1]), "+v"(acc[ai][1][m][0]), "+v"(acc[ai][1][m][1]));
                if (m & 1) asm volatile("" ::: "memory"); }
        const bool bad1 = bad;
        bad = st2.run(acc, u, wr, wc, fr, fq, lds, wid, lane) || bad;
#pragma unroll
        for (int ai = 0; ai < 2; ++ai)
#pragma unroll
            for (int m = 0; m < 4; ++m) { const int r = ai * HALF + wr * 64 + m * 16 + fr; const f32x2v sr = S[r]; const size_t off = (size_t)(u.pm * BM + r) * ldc + col0;
#pragma unroll
                for (int bj = 0; bj < 2; ++bj)
#pragma unroll
                    for (int n = 0; n < 2; ++n) { const f32x4 x1 = acc[ai][bj][m][n]; *(f32x4*)(out + off + bj * HALF + n * 16) = bad1 ? (f32x4){qnan, qnan, qnan, qnan} : x1;
                        const f32x4 o = (x1 - sr.x) * sr.y; u32x2v w; w.x = cvt_pk_bf16(o[0], o[1]); w.y = cvt_pk_bf16(o[2], o[3]);
                        if (bad) { w.x = 0x7fc07fc0u; w.y = 0x7fc07fc0u; } *(u32x2v*)(xn + off + bj * HALF + n * 16) = w; }
                asm volatile("" ::: "memory"); }
    }
};

template <class Epi, class Sched, bool STAMP = false>
__device__ __forceinline__ void gemm_phase(PG8_LAS unsigned char* lds, const Gemm g, const Sched& S, const Epi& E, unsigned long long* stamps, const int tid_in) {
    const int tid = tid_in, wid = __builtin_amdgcn_readfirstlane(tid >> 6), lane = tid & 63, wr = wid >> 2, wc = wid & 3, fr = lane & 15, fq = lane >> 4;
    const int K = g.K, nt = K / BK;
    int ts_lo = 0, ts_hi = 0, nts = 0; const unsigned long long rt_entry = STAMP ? (unsigned long long)wall_clock64() : 0ull;
#define PG8_STAMP() do { if (STAMP && wid == 0 && nts < 64) { const unsigned long long _c = (unsigned long long)clock64(); \
        ts_lo = (lane == nts) ? (int)(unsigned)_c : ts_lo; ts_hi = (lane == nts) ? (int)(unsigned)(_c >> 32) : ts_hi; ++nts; } } while (0)
    PG8_STAMP();
    unsigned voffA[2], voffB[2];
#pragma unroll
    for (int i = 0; i < 2; ++i) { int R, C; stage_rc(tid * 16 + i * 8192, R, C); const int Rb = Epi::PERM ? ((R & ~31) + perm32(R & 31)) : R;
        voffA[i] = (unsigned)(R * K + C) * 2u; voffB[i] = (unsigned)(Rb * K + C) * 2u; }
    const size_t kstep = (size_t)(BK * 2);
    const size_t hstep = (size_t)HALF * K * 2;
    const size_t tstep = 2 * hstep;
    const unsigned ldsw = (unsigned)wid * 1024u;
    const int aoff = lds_byte(wr * 64 + fr, fq * 8), boff = lds_byte(wc * 32 + fr, fq * 8);
#define PG8_SA(b, h) (((b) * 2 + (h)) * HTB)
#define PG8_SB(b, h) ((4 + (b) * 2 + (h)) * HTB)
#define PG8_STAGE(bufoff, gbase, voff) do { _Pragma("unroll") for (int _i = 0; _i < 2; ++_i) \
        __builtin_amdgcn_global_load_lds((const unsigned*)((const char*)(gbase) + (voff)[_i]), (PG8_LAS unsigned*)(lds + (bufoff) + ldsw + _i * 8192), 16, 0, 0); } while (0)
#define PG8_LDA(dst, b, h) do { _Pragma("unroll") for (int m = 0; m < 4; ++m) _Pragma("unroll") for (int k = 0; k < 2; ++k) dst[m][k] = *(const PG8_LAS bf16x8*)(lds + PG8_SA(b, h) + aoff + m * 2048 + k * 1024); } while (0)
#define PG8_LDB(dst, b, h) do { _Pragma("unroll") for (int n = 0; n < 2; ++n) _Pragma("unroll") for (int k = 0; k < 2; ++k) dst[n][k] = *(const PG8_LAS bf16x8*)(lds + PG8_SB(b, h) + boff + n * 2048 + k * 1024); } while (0)
#define PG8_MMA(ai, bj, At, Bt) do { __builtin_amdgcn_s_setprio(1); _Pragma("unroll") for (int m = 0; m < 4; ++m) _Pragma("unroll") for (int n = 0; n < 2; ++n) _Pragma("unroll") for (int k = 0; k < 2; ++k) \
        acc[ai][bj][m][n] = __builtin_amdgcn_mfma_f32_16x16x32_bf16(Bt[n][k], At[m][k], acc[ai][bj][m][n], 0, 0, 0); __builtin_amdgcn_s_setprio(0); } while (0)
#define PG8_WAIT_V(n) asm volatile("s_waitcnt vmcnt(" #n ")" ::: "memory")
#define PG8_WAIT_L(n) asm volatile("s_waitcnt lgkmcnt(" #n ")" ::: "memory")
#define PG8_BAR __builtin_amdgcn_s_barrier()
#define PG8_SCHED __builtin_amdgcn_sched_barrier(0)
    Unit cur, nxt; int ui = 0;
    if (!S.next(0, cur)) return;
    f32x4 acc[2][2][4][2];
#pragma unroll
    for (int a = 0; a < 2; ++a)
#pragma unroll
        for (int b = 0; b < 2; ++b)
#pragma unroll
            for (int m = 0; m < 4; ++m)
#pragma unroll
                for (int n = 0; n < 2; ++n) acc[a][b][m][n] = (f32x4){0.f, 0.f, 0.f, 0.f};
    bf16x8 At[4][2], B0[2][2], B1[2][2];
    const char* cA = (const char*)g.A + (size_t)cur.pm * tstep; const char* cB = (const char*)g.Bt + (size_t)cur.pn * tstep;
    S.a_ready(cur);
    PG8_STAGE(PG8_SB(0, 0), cB, voffB); PG8_STAGE(PG8_SA(0, 0), cA, voffA); PG8_STAGE(PG8_SB(0, 1), cB + hstep, voffB); PG8_STAGE(PG8_SA(0, 1), cA + hstep, voffA);
    if (wr == 1) PG8_BAR;
    PG8_WAIT_V(4); PG8_BAR;
    PG8_STAGE(PG8_SB(1, 0), cB + kstep, voffB); PG8_STAGE(PG8_SA(1, 0), cA + kstep, voffA); PG8_STAGE(PG8_SB(1, 1), cB + hstep + kstep, voffB);
    PG8_WAIT_V(6); PG8_BAR;
    PG8_STAMP();
    for (;;) {
        const bool has_next = S.next(ui + 1, nxt);
        const char* nA = has_next ? (const char*)g.A + (size_t)nxt.pm * tstep : cA; const char* nB = has_next ? (const char*)g.Bt + (size_t)nxt.pn * tstep : cB;
        for (int t = 0; t < nt; t += 2) {
            const bool last = (t == nt - 2);
            const char* a1 = cA + (size_t)(t + 1) * kstep;
            const char* a2 = last ? nA : cA + (size_t)(t + 2) * kstep; const char* b2 = last ? nB : cB + (size_t)(t + 2) * kstep;
            const char* a3 = a2 + kstep; const char* b3 = b2 + kstep;
            if (last && has_next) S.a_ready(nxt);
            PG8_LDB(B0, 0, 0); PG8_SCHED; PG8_LDA(At, 0, 0); PG8_STAGE(PG8_SA(1, 1), a1 + hstep, voffA);
            PG8_WAIT_L(8); PG8_BAR; PG8_WAIT_L(0); PG8_MMA(0, 0, At, B0); PG8_BAR; PG8_SCHED;
            PG8_LDB(B1, 0, 1); PG8_STAGE(PG8_SB(0, 0), b2, voffB);
            PG8_BAR; PG8_WAIT_L(0); PG8_MMA(0, 1, At, B1); PG8_BAR;
            PG8_LDA(At, 0, 1); PG8_STAGE(PG8_SA(0, 0), a2, voffA);
            PG8_BAR; PG8_WAIT_L(0); PG8_MMA(1, 0, At, B0); PG8_BAR; PG8_SCHED;
            PG8_STAGE(PG8_SB(0, 1), b2 + hstep, voffB);
            PG8_WAIT_V(6); PG8_BAR; PG8_MMA(1, 1, At, B1); PG8_BAR;
            PG8_LDB(B0, 1, 0); PG8_SCHED; PG8_LDA(At, 1, 0); PG8_STAGE(PG8_SA(0, 1), a2 + hstep, voffA);
            PG8_WAIT_L(8); PG8_BAR; PG8_WAIT_L(0); PG8_MMA(0, 0, At, B0); PG8_BAR; PG8_SCHED;
            PG8_LDB(B1, 1, 1); PG8_STAGE(PG8_SB(1, 0), b3, voffB);
            PG8_BAR; PG8_WAIT_L(0); PG8_MMA(0, 1, At, B1); PG8_BAR;
            PG8_LDA(At, 1, 1); PG8_STAGE(PG8_SA(1, 0), a3, voffA);
            PG8_BAR; PG8_WAIT_L(0); PG8_MMA(1, 0, At, B0); PG8_BAR; PG8_SCHED;
            PG8_STAGE(PG8_SB(1, 1), b3 + hstep, voffB);
            PG8_WAIT_V(6); PG8_BAR; PG8_MMA(1, 1, At, B1); PG8_BAR;
        }
        PG8_STAMP();
        if constexpr (!Epi::AFTER_DRAIN) { E(acc, cur, wr, wc, fr, fq); S.done(cur); }
        PG8_STAMP();
        if (!has_next) break;
#pragma unroll
        for (int a = 0; a < 2; ++a)
#pragma unroll
            for (int b = 0; b < 2; ++b)
#pragma unroll
                for (int m = 0; m < 4; ++m)
#pragma unroll
                    for (int n = 0; n < 2; ++n) acc[a][b][m][n] = (f32x4){0.f, 0.f, 0.f, 0.f};
        cur = nxt; cA = nA; cB = nB; ++ui;
    }
    PG8_WAIT_V(0);
    if (wr == 0) PG8_BAR;
    PG8_BAR;
    if constexpr (Epi::AFTER_DRAIN) { E.fused(acc, cur, wr, wc, fr, fq, lds, wid, lane); S.done(cur); }
    PG8_STAMP();
    if (STAMP && wid == 0) { stamps[lane] = lane < nts ? (((unsigned long long)(unsigned)ts_hi << 32) | (unsigned)ts_lo) : 0ull;
        if (lane == 62) stamps[62] = rt_entry; if (lane == 63) stamps[63] = (unsigned long long)wall_clock64(); }
#undef PG8_STAMP
#undef PG8_SA
#undef PG8_SB
#undef PG8_STAGE
#undef PG8_LDA
#undef PG8_LDB
#undef PG8_MMA
#undef PG8_WAIT_V
#undef PG8_WAIT_L
#undef PG8_BAR
#undef PG8_SCHED
}
}

#define LAS __attribute__((address_space(3)))
using pg8::bf16_t; using pg8::bf16x8; using pg8::f32x4; using pg8::u32x4; using pg8::Unit; using pg8::BM; using pg8::HALF;
typedef unsigned u32x2 __attribute__((ext_vector_type(2)));

#ifndef MK_COOP
#define MK_COOP 1
#endif
#ifndef MK_ONLY
#define MK_ONLY -1
#endif
#define EN(kk) (MK_ONLY < 0 || MK_ONLY == (kk))

constexpr int M_TOK = 16384, DM = 1024, SEQ = 2048, INW = 7168, DFF = 4096, DEPTH = 4;
constexpr float ALPHA = 1.6817928305074292f;
constexpr float LN_EPS = 1e-5f;
constexpr int LDS_BYTES = 147456;
constexpr int NPHASE = 1 + 9 * DEPTH;

constexpr size_t WT_IN = 0, WT_PA = 7340032, WT_PB = 7864320, WT_PC = 8126464, WT_PD = 8388608, WT_O = 8650752, WT_M1 = 9699328, WT_M2 = 13893632, WT_END = 18087936;
constexpr size_t OFF_WT = 0;
constexpr size_t OFF_ROPE = WT_END * 2;
constexpr size_t OFF_KPART = OFF_ROPE + 524288;
constexpr size_t OFF_XN = OFF_KPART + 524288;
constexpr size_t OFF_Z = OFF_XN + 33554432;
constexpr size_t OFF_QR = OFF_Z + 234881024;
constexpr size_t OFF_KR = OFF_QR + 16777216;
constexpr size_t OFF_VT = OFF_KR + 16777216;
constexpr size_t OFF_YA = OFF_VT + 16777216;
constexpr size_t OFF_YB = OFF_YA + 16777216;
constexpr size_t OFF_YC = OFF_YB + 8388608;
constexpr size_t OFF_YD = OFF_YC + 8388608;
constexpr size_t OFF_X1 = OFF_YD + 8388608;
constexpr size_t WS_END = OFF_X1 + 67108864;
constexpr size_t OFF_H = OFF_Z;
constexpr size_t OFF_MIX = OFF_QR;

struct Params { const float* in[21]; float* out; unsigned char* ws; int ph_lo, ph_hi; };

__device__ __forceinline__ float bf_lo(unsigned w) { return __uint_as_float(w << 16); }
__device__ __forceinline__ float bf_hi(unsigned w) { return __uint_as_float(w & 0xffff0000u); }
__device__ __forceinline__ unsigned pk(float lo, float hi) { return pg8::cvt_pk_bf16(lo, hi); }
__device__ __forceinline__ float sigm(float x) { return __builtin_amdgcn_rcpf(1.0f + __builtin_amdgcn_exp2f(-1.4426950408889634f * x)); }
__device__ __forceinline__ float wsum(float v) { v += __shfl_xor(v, 1); v += __shfl_xor(v, 2); v += __shfl_xor(v, 4); v += __shfl_xor(v, 8); v += __shfl_xor(v, 16); v += __shfl_xor(v, 32); return v; }

struct EpiRelu2 {
    static constexpr bool PERM = true, AFTER_DRAIN = false;
    bf16_t* O; int ldc;
    __device__ __forceinline__ void operator()(const f32x4 (&acc)[2][2][4][2], const Unit& u, int wr, int wc, int fr, int fq) const {
        const int row0 = u.pm * BM + wr * 64 + fr, col0 = u.pn * BM + wc * 32 + 8 * fq;
#pragma unroll
        for (int ai = 0; ai < 2; ++ai)
#pragma unroll
            for (int m = 0; m < 4; ++m) { bf16_t* rowp = O + (size_t)(row0 + ai * HALF + m * 16) * ldc + col0;
#pragma unroll
                for (int bj = 0; bj < 2; ++bj) { f32x4 v0 = acc[ai][bj][m][0], v1 = acc[ai][bj][m][1];
#pragma unroll
                    for (int j = 0; j < 4; ++j) { const float a = fmaxf(v0[j], 0.f), b = fmaxf(v1[j], 0.f); v0[j] = a * a; v1[j] = b * b; }
                    u32x4 w; w.x = pk(v0[0], v0[1]); w.y = pk(v0[2], v0[3]); w.z = pk(v1[0], v1[1]); w.w = pk(v1[2], v1[3]);
                    *(u32x4*)(rowp + bj * HALF) = w; } }
    }
};
struct EpiGate {
    static constexpr bool PERM = true, AFTER_DRAIN = false;
    const bf16_t* G; bf16_t* MIX; int FIRST;
    __device__ __forceinline__ void operator()(const f32x4 (&acc)[2][2][4][2], const Unit& u, int wr, int wc, int fr, int fq) const {
        const int row0 = u.pm * BM + wr * 64 + fr, col0 = u.pn * BM + wc * 32 + 8 * fq;
        const unsigned goff0 = ((unsigned)row0 * INW + col0) * 2u, moff0 = ((unsigned)row0 * DM + col0) * 2u;
        const char* Gb = (const char*)G; char* Mb = (char*)MIX;
#pragma unroll
        for (int ai = 0; ai < 2; ++ai)
#pragma unroll
            for (int m = 0; m < 4; ++m) {
#pragma unroll
                for (int bj = 0; bj < 2; ++bj) {
                    const unsigned goff = goff0 + (unsigned)((ai * HALF + m * 16) * INW + bj * HALF) * 2u, moff = moff0 + (unsigned)((ai * HALF + m * 16) * DM + bj * HALF) * 2u;
                    const u32x4 gl = *(const u32x4*)(Gb + goff);
                    u32x4 old = {0u, 0u, 0u, 0u}; if (!FIRST) old = *(const u32x4*)(Mb + moff);
                    const f32x4 v0 = acc[ai][bj][m][0], v1 = acc[ai][bj][m][1];
                    float o0 = sigm(bf_lo(gl.x)) * v0[0], o1 = sigm(bf_hi(gl.x)) * v0[1], o2 = sigm(bf_lo(gl.y)) * v0[2], o3 = sigm(bf_hi(gl.y)) * v0[3];
                    float o4 = sigm(bf_lo(gl.z)) * v1[0], o5 = sigm(bf_hi(gl.z)) * v1[1], o6 = sigm(bf_lo(gl.w)) * v1[2], o7 = sigm(bf_hi(gl.w)) * v1[3];
                    { o0 += bf_lo(old.x); o1 += bf_hi(old.x); o2 += bf_lo(old.y); o3 += bf_hi(old.y); o4 += bf_lo(old.z); o5 += bf_hi(old.z); o6 += bf_lo(old.w); o7 += bf_hi(old.w); }
                    u32x4 w; w.x = pk(o0, o1); w.y = pk(o2, o3); w.z = pk(o4, o5); w.w = pk(o6, o7);
                    *(u32x4*)(Mb + moff) = w; }
                asm volatile("" ::: "memory"); }
    }
};
struct EpiRes {
    static constexpr bool PERM = false, AFTER_DRAIN = false;
    const float* base; float* out;
    __device__ __forceinline__ void operator()(const f32x4 (&acc)[2][2][4][2], const Unit& u, int wr, int wc, int fr, int fq) const {
        const int row0 = u.pm * BM + wr * 64 + fr, col0 = u.pn * BM + wc * 32 + 4 * fq;
#pragma unroll
        for (int ai = 0; ai < 2; ++ai)
#pragma unroll
            for (int m = 0; m < 4; ++m) { const size_t off = (size_t)(row0 + ai * HALF + m * 16) * DM + col0;
#pragma unroll
                for (int bj = 0; bj < 2; ++bj)
#pragma unroll
                    for (int n = 0; n < 2; ++n) { const size_t o = off + bj * HALF + n * 16; const f32x4 b = *(const f32x4*)(base + o); *(f32x4*)(out + o) = b * ALPHA + acc[ai][bj][m][n]; } }
    }
};

__device__ __forceinline__ void convert_layer(const Params& p, int l, LAS unsigned char* lds, const int tid, const int bid) {
    bf16_t* WT = (bf16_t*)(p.ws + OFF_WT);
    LAS float* tile = (LAS float*)lds;
    for (int t = bid; t < 4416; t += gridDim.x) {
        const float* src; int K, N, tt; size_t dst;
        if (t < 1792)      { src = p.in[1]  + (size_t)l * 1024 * 7168; K = 1024; N = 7168; dst = WT_IN; tt = t; }
        else if (t < 1920) { src = p.in[10] + (size_t)l * 512 * 1024;  K = 512;  N = 1024; dst = WT_PA; tt = t - 1792; }
        else if (t < 1984) { src = p.in[11] + (size_t)l * 256 * 1024;  K = 256;  N = 1024; dst = WT_PB; tt = t - 1920; }
        else if (t < 2048) { src = p.in[12] + (size_t)l * 256 * 1024;  K = 256;  N = 1024; dst = WT_PC; tt = t - 1984; }
        else if (t < 2112) { src = p.in[13] + (size_t)l * 256 * 1024;  K = 256;  N = 1024; dst = WT_PD; tt = t - 2048; }
        else if (t < 2368) { src = p.in[14] + (size_t)l * 1024 * 1024; K = 1024; N = 1024; dst = WT_O;  tt = t - 2112; }
        else if (t < 3392) { src = p.in[17] + (size_t)l * 1024 * 4096; K = 1024; N = 4096; dst = WT_M1; tt = t - 2368; }
        else               { src = p.in[18] + (size_t)l * 4096 * 1024; K = 4096; N = 1024; dst = WT_M2; tt = t - 3392; }
        const int ntn = N >> 6, k0 = (tt / ntn) * 64, n0 = (tt % ntn) * 64;
#pragma unroll
        for (int i = 0; i < 8; ++i) { const int k = (tid >> 6) + 8 * i; tile[k * 65 + (tid & 63)] = src[(size_t)(k0 + k) * N + n0 + (tid & 63)]; }
        __syncthreads();
        { const int n = tid >> 3, kc = tid & 7; float v[8];
#pragma unroll
          for (int j = 0; j < 8; ++j) v[j] = tile[(kc * 8 + j) * 65 + n];
          u32x4 w; w.x = pk(v[0], v[1]); w.y = pk(v[2], v[3]); w.z = pk(v[4], v[5]); w.w = pk(v[6], v[7]);
          *(u32x4*)(WT + dst + (size_t)(n0 + n) * K + k0 + kc * 8) = w; }
        __syncthreads();
    }
}

__device__ __forceinline__ void phase0(const Params& p, LAS unsigned char* lds, const int tid, const int bid) {
    const size_t gtid = (size_t)bid * 512 + tid, gsz = (size_t)gridDim.x * 512;
    float2* rope = (float2*)(p.ws + OFF_ROPE);
    { const int i0 = tid & 31;
        float inv = 1.0f;
        inv = (i0 == 1) ? 7.498942018e-01f : inv;
        inv = (i0 == 2) ? 5.623413324e-01f : inv;
        inv = (i0 == 3) ? 4.216965139e-01f : inv;
        inv = (i0 == 4) ? 3.162277639e-01f : inv;
        inv = (i0 == 5) ? 2.371373773e-01f : inv;
        inv = (i0 == 6) ? 1.778279394e-01f : inv;
        inv = (i0 == 7) ? 1.333521456e-01f : inv;
        inv = (i0 == 8) ? 1.000000015e-01f : inv;
        inv = (i0 == 9) ? 7.498942316e-02f : inv;
        inv = (i0 == 10) ? 5.623413250e-02f : inv;
        inv = (i0 == 11) ? 4.216964915e-02f : inv;
        inv = (i0 == 12) ? 3.162277490e-02f : inv;
        inv = (i0 == 13) ? 2.371373773e-02f : inv;
        inv = (i0 == 14) ? 1.778279431e-02f : inv;
        inv = (i0 == 15) ? 1.333521400e-02f : inv;
        inv = (i0 == 16) ? 9.999999776e-03f : inv;
        inv = (i0 == 17) ? 7.498942316e-03f : inv;
        inv = (i0 == 18) ? 5.623413250e-03f : inv;
        inv = (i0 == 19) ? 4.216964822e-03f : inv;
        inv = (i0 == 20) ? 3.162277630e-03f : inv;
        inv = (i0 == 21) ? 2.371373819e-03f : inv;
        inv = (i0 == 22) ? 1.778279431e-03f : inv;
        inv = (i0 == 23) ? 1.333521446e-03f : inv;
        inv = (i0 == 24) ? 1.000000047e-03f : inv;
        inv = (i0 == 25) ? 7.498941850e-04f : inv;
        inv = (i0 == 26) ? 5.623413017e-04f : inv;
        inv = (i0 == 27) ? 4.216965172e-04f : inv;
        inv = (i0 == 28) ? 3.162277571e-04f : inv;
        inv = (i0 == 29) ? 2.371373703e-04f : inv;
        inv = (i0 == 30) ? 1.778279402e-04f : inv;
        inv = (i0 == 31) ? 1.333521504e-04f : inv;

        for (size_t idx = gtid; idx < 65536; idx += gsz) { const int t = (int)(idx >> 5);
            const float ang = (float)t * inv;
            float rev = ang * 0.15915494309189535f; rev -= floorf(rev);
            const float ang_hi = rev;
            rope[idx] = make_float2(__builtin_amdgcn_cosf(ang_hi), __builtin_amdgcn_sinf(ang_hi)); } }
    const float4* x4 = (const float4*)p.in[0]; u32x4* xn = (u32x4*)(p.ws + OFF_XN);
    for (size_t idx = gtid; idx < (size_t)M_TOK * DM / 8; idx += gsz) { const float4 a = x4[2 * idx], b = x4[2 * idx + 1];
        u32x4 w; w.x = pk(a.x, a.y); w.y = pk(a.z, a.w); w.z = pk(b.x, b.y); w.w = pk(b.z, b.w); xn[idx] = w; }
    convert_layer(p, 0, lds, tid, bid);
}

__device__ __forceinline__ void ln_phase(float* X, const float* gam, const float* bet, bf16_t* XN, const int tid, const int bid) {
    const int lane = tid & 63, wave = tid >> 6;
    f32x4 g[4], b[4];
#pragma unroll
    for (int i = 0; i < 4; ++i) { g[i] = *(const f32x4*)(gam + lane * 4 + 256 * i); b[i] = *(const f32x4*)(bet + lane * 4 + 256 * i); }
    for (int r = bid * 8 + wave; r < M_TOK; r += gridDim.x * 8) {
        float* xr = X + (size_t)r * DM + lane * 4; f32x4 v[4]; float s = 0.f;
#pragma unroll
        for (int i = 0; i < 4; ++i) { v[i] = *(const f32x4*)(xr + 256 * i); s += (v[i][0] + v[i][1]) + (v[i][2] + v[i][3]); }
        const float mu = wsum(s) * (1.0f / 1024.0f); float q = 0.f;
#pragma unroll
        for (int i = 0; i < 4; ++i) { v[i] = v[i] - mu; q += (v[i][0] * v[i][0] + v[i][1] * v[i][1]) + (v[i][2] * v[i][2] + v[i][3] * v[i][3]); }
        const float rstd = 1.0f / sqrtf(wsum(q) * (1.0f / 1024.0f) + LN_EPS);
#pragma unroll
        for (int i = 0; i < 4; ++i) { const f32x4 y = v[i] * rstd * g[i] + b[i]; *(f32x4*)(xr + 256 * i) = y;
            u32x2 w; w.x = pk(y[0], y[1]); w.y = pk(y[2], y[3]); *(u32x2*)(XN + (size_t)r * DM + lane * 4 + 256 * i) = w; }
    }
}

__device__ __forceinline__ void mixers_phase(const Params& p, int l, LAS unsigned char* lds, const int tid, const int bid) {
    const int lane = tid & 63, wave = tid >> 6;
    const bf16_t* Z = (const bf16_t*)(p.ws + OFF_Z);
    const float* rope = (const float*)(p.ws + OFF_ROPE);
    bf16_t* QR = (bf16_t*)(p.ws + OFF_QR); bf16_t* KR = (bf16_t*)(p.ws + OFF_KR); bf16_t* VT = (bf16_t*)(p.ws + OFF_VT);
    float* kpart = (float*)(p.ws + OFF_KPART);
    bf16_t* YB = (bf16_t*)(p.ws + OFF_YB); bf16_t* YC = (bf16_t*)(p.ws + OFF_YC); bf16_t* YD = (bf16_t*)(p.ws + OFF_YD);
    for (int tile = bid; tile < 256; tile += gridDim.x) {
        const int b = tile >> 5, t0 = (tile & 31) * 64, row0 = tile * 64;
        {
            const int cgp = tid & 63, qk = cgp >> 5, head = (cgp >> 2) & 7, dch = cgp & 3, tg = tid >> 6;
            float ks[16];
#pragma unroll
            for (int e = 0; e < 16; ++e) ks[e] = 0.f;
            bf16_t* dstb = (qk ? KR : QR) + ((size_t)(b * 8 + head) * SEQ) * 64 + dch * 8;
#pragma unroll 2
            for (int i = 0; i < 8; ++i) { const int tl = tg * 8 + i, t = t0 + tl;
                const bf16_t* src = Z + (size_t)(row0 + tl) * INW + qk * 512 + head * 64 + dch * 8;
                const u32x4 lo = *(const u32x4*)src, hi = *(const u32x4*)(src + 32);
                const f32x4* cs = (const f32x4*)(rope + ((size_t)t * 32 + dch * 8) * 2);
                const f32x4 c0 = cs[0], c1 = cs[1], c2 = cs[2], c3 = cs[3];
                float x1[8] = {bf_lo(lo.x), bf_hi(lo.x), bf_lo(lo.y), bf_hi(lo.y), bf_lo(lo.z), bf_hi(lo.z), bf_lo(lo.w), bf_hi(lo.w)};
                float x2[8] = {bf_lo(hi.x), bf_hi(hi.x), bf_lo(hi.y), bf_hi(hi.y), bf_lo(hi.z), bf_hi(hi.z), bf_lo(hi.w), bf_hi(hi.w)};
                float cc[8] = {c0[0], c0[2], c1[0], c1[2], c2[0], c2[2], c3[0], c3[2]};
                float ss[8] = {c0[1], c0[3], c1[1], c1[3], c2[1], c2[3], c3[1], c3[3]};
                float o1[8], o2[8];
#pragma unroll
                for (int e = 0; e < 8; ++e) { o1[e] = x1[e] * cc[e] - x2[e] * ss[e]; o2[e] = x2[e] * cc[e] + x1[e] * ss[e]; ks[e] += o1[e]; ks[8 + e] += o2[e]; }
                u32x4 w1, w2; w1.x = pk(o1[0], o1[1]); w1.y = pk(o1[2], o1[3]); w1.z = pk(o1[4], o1[5]); w1.w = pk(o1[6], o1[7]);
                w2.x = pk(o2[0], o2[1]); w2.y = pk(o2[2], o2[3]); w2.z = pk(o2[4], o2[5]); w2.w = pk(o2[6], o2[7]);
                bf16_t* d = dstb + (size_t)t * 64; *(u32x4*)d = w1; *(u32x4*)(d + 32) = w2; }
            LAS float* red = (LAS float*)lds;
            if (qk) {
#pragma unroll
                for (int e = 0; e < 8; ++e) { red[tg * 512 + head * 64 + dch * 8 + e] = ks[e]; red[tg * 512 + head * 64 + 32 + dch * 8 + e] = ks[8 + e]; } }
        }
        {
            LAS unsigned char* vst = lds + 16384;
#pragma unroll
            for (int i = 0; i < 8; ++i) { const int idx = tid + 512 * i, r = idx >> 6, ch = idx & 63;
                *(LAS u32x4*)(vst + r * 1024 + ch * 16) = *(const u32x4*)(Z + (size_t)(row0 + r) * INW + 1024 + ch * 8); }
        }
        {
            const float* wsc = p.in[9] + (size_t)l * 3 * 256;
#pragma unroll 1
            for (int i = 0; i < 4; ++i) { const int idx = tid + 512 * i, tl = idx >> 5, c0 = (idx & 31) * 8, t = t0 + tl;
                float acc[8];
#pragma unroll
                for (int e = 0; e < 8; ++e) acc[e] = 0.f;
#pragma unroll
                for (int j = 0; j < 3; ++j) { if (t - 2 + j >= 0) { const bf16_t* zr = Z + (size_t)(row0 + tl - 2 + j) * INW;
                    const u32x4 xx = *(const u32x4*)(zr + 2304 + c0), cv = *(const u32x4*)(zr + 2816 + c0);
                    const f32x4 wa = *(const f32x4*)(wsc + j * 256 + c0), wb = *(const f32x4*)(wsc + j * 256 + c0 + 4);
                    acc[0] += wa[0] * (bf_lo(xx.x) * bf_lo(cv.x)); acc[1] += wa[1] * (bf_hi(xx.x) * bf_hi(cv.x));
                    acc[2] += wa[2] * (bf_lo(xx.y) * bf_lo(cv.y)); acc[3] += wa[3] * (bf_hi(xx.y) * bf_hi(cv.y));
                    acc[4] += wb[0] * (bf_lo(xx.z) * bf_lo(cv.z)); acc[5] += wb[1] * (bf_hi(xx.z) * bf_hi(cv.z));
                    acc[6] += wb[2] * (bf_lo(xx.w) * bf_lo(cv.w)); acc[7] += wb[3] * (bf_hi(xx.w) * bf_hi(cv.w)); } }
                const u32x4 bb = *(const u32x4*)(Z + (size_t)(row0 + tl) * INW + 2560 + c0);
                u32x4 w; w.x = pk(bf_lo(bb.x) * acc[0], bf_hi(bb.x) * acc[1]); w.y = pk(bf_lo(bb.y) * acc[2], bf_hi(bb.y) * acc[3]);
                w.z = pk(bf_lo(bb.z) * acc[4], bf_hi(bb.z) * acc[5]); w.w = pk(bf_lo(bb.w) * acc[6], bf_hi(bb.w) * acc[7]);
                *(u32x4*)(YD + (size_t)(row0 + tl) * 256 + c0) = w; }
        }
        __syncthreads();
        {
            LAS float* red = (LAS float*)lds; float s = 0.f;
#pragma unroll
            for (int g8 = 0; g8 < 8; ++g8) s += red[g8 * 512 + tid];
            kpart[(size_t)tile * 512 + tid] = s;
            LAS unsigned short* vst = (LAS unsigned short*)(lds + 16384);
            const int h = tid >> 6, d = tid & 63;
            bf16_t* dst = VT + ((size_t)((b * 8 + h) * 64 + d)) * SEQ + t0;
#pragma unroll
            for (int g8 = 0; g8 < 8; ++g8) { unsigned e[8];
#pragma unroll
                for (int j = 0; j < 8; ++j) e[j] = vst[(g8 * 8 + j) * 512 + tid];
                u32x4 w; w.x = e[0] | (e[1] << 16); w.y = e[2] | (e[3] << 16); w.z = e[4] | (e[5] << 16); w.w = e[6] | (e[7] << 16);
                *(u32x4*)(dst + g8 * 8) = w; }
        }
        __syncthreads();
        {
            LAS float* U = (LAS float*)lds;
            for (int idx = tid; idx < 94 * 32; idx += 512) { const int r = idx >> 5, c0 = (idx & 31) * 8, tl = r - 30;
                f32x4 u0 = {0.f, 0.f, 0.f, 0.f}, u1 = {0.f, 0.f, 0.f, 0.f};
                if (t0 + tl >= 0) { const bf16_t* zr = Z + (size_t)(row0 + tl) * INW;
                    const u32x4 a = *(const u32x4*)(zr + 1536 + c0), g = *(const u32x4*)(zr + 1792 + c0);
                    u0[0] = bf_lo(a.x) * sigm(bf_lo(g.x)); u0[1] = bf_hi(a.x) * sigm(bf_hi(g.x)); u0[2] = bf_lo(a.y) * sigm(bf_lo(g.y)); u0[3] = bf_hi(a.y) * sigm(bf_hi(g.y));
                    u1[0] = bf_lo(a.z) * sigm(bf_lo(g.z)); u1[1] = bf_hi(a.z) * sigm(bf_hi(g.z)); u1[2] = bf_lo(a.w) * sigm(bf_lo(g.w)); u1[3] = bf_hi(a.w) * sigm(bf_hi(g.w)); }
                *(LAS f32x4*)(U + r * 256 + c0) = u0; *(LAS f32x4*)(U + r * 256 + c0 + 4) = u1; }
            __syncthreads();
            const int c = tid & 255, grp = tid >> 8;
            const float* wdw = p.in[3] + (size_t)l * 31 * 256 + c;
            float w[31];
#pragma unroll
            for (int j = 0; j < 31; ++j) w[j] = wdw[j * 256];
            const float bias = p.in[4][l * 256 + c];
            float cv[32];
#pragma unroll
            for (int o = 0; o < 32; ++o) cv[o] = bias;
#pragma unroll
            for (int r = 0; r < 62; ++r) { const float uv = U[(grp * 32 + r) * 256 + c];
#pragma unroll
                for (int o = 0; o < 32; ++o) { if (r - o >= 0 && r - o <= 30) cv[o] += w[r - o] * uv; } }
            __syncthreads();
#pragma unroll
            for (int o = 0; o < 32; ++o) U[(grp * 32 + o) * 256 + c] = cv[o];
            __syncthreads();
            const f32x4 g4 = *(const f32x4*)(p.in[5] + l * 256 + lane * 4), b4 = *(const f32x4*)(p.in[6] + l * 256 + lane * 4);
#pragma unroll 2
            for (int i = 0; i < 8; ++i) { const int tl = wave * 8 + i;
                f32x4 v = *(LAS f32x4*)(U + tl * 256 + lane * 4);
                const float mu = wsum((v[0] + v[1]) + (v[2] + v[3])) * (1.0f / 256.0f);
                v = v - mu;
                const float rstd = 1.0f / sqrtf(wsum((v[0] * v[0] + v[1] * v[1]) + (v[2] * v[2] + v[3] * v[3])) * (1.0f / 256.0f) + LN_EPS);
                f32x4 y = v * rstd * g4 + b4;
#pragma unroll
                for (int e = 0; e < 4; ++e) y[e] = y[e] * sigm(y[e]);
                u32x2 wv; wv.x = pk(y[0], y[1]); wv.y = pk(y[2], y[3]);
                *(u32x2*)(YB + (size_t)(row0 + tl) * 256 + lane * 4) = wv; }
            __syncthreads();
        }
        {
            LAS float* D = (LAS float*)lds;
            LAS float* WL = (LAS float*)(lds + 65536);
            const float* wp = p.in[7] + (size_t)l * 16384;
#pragma unroll
            for (int i = 0; i < 8; ++i) { const int idx = tid + 512 * i; *(LAS f32x4*)(WL + idx * 4) = *(const f32x4*)(wp + idx * 4); }
            const int c = tid & 255, grp = tid >> 8, gi = c >> 6, W = 2 << gi;
            const unsigned short* zc = (const unsigned short*)Z + (size_t)row0 * INW + 2048 + c;
            const int ts = grp * 32;
            float sum = 0.f;
            for (int k = 1; k < W; ++k) { if (t0 + ts - k >= 0) sum += __uint_as_float((unsigned)zc[(ptrdiff_t)(ts - k) * INW] << 16); }
            for (int o = 0; o < 32; ++o) { const int tl = ts + o, t = t0 + tl;
                const float un = __uint_as_float((unsigned)zc[(ptrdiff_t)tl * INW] << 16);
                sum += un;
                const int cnt = (t + 1 < W) ? (t + 1) : W;
                D[tl * 256 + c] = sum / (float)cnt - un;
                if (t - W + 1 >= 0) sum -= __uint_as_float((unsigned)zc[(ptrdiff_t)(tl - W + 1) * INW] << 16); }
            __syncthreads();
            const int dd = c & 63;
            float acc[32];
#pragma unroll
            for (int o = 0; o < 32; ++o) acc[o] = 0.f;
#pragma unroll 1
            for (int c4 = 0; c4 < 16; ++c4) {
                const float w0 = WL[(gi * 64 + c4 * 4 + 0) * 64 + dd], w1 = WL[(gi * 64 + c4 * 4 + 1) * 64 + dd], w2 = WL[(gi * 64 + c4 * 4 + 2) * 64 + dd], w3 = WL[(gi * 64 + c4 * 4 + 3) * 64 + dd];
#pragma unroll
                for (int o = 0; o < 32; ++o) { const f32x4 dv = *(LAS f32x4*)(D + (ts + o) * 256 + gi * 64 + c4 * 4);
                    acc[o] += (dv[0] * w0 + dv[1] * w1) + (dv[2] * w2 + dv[3] * w3); } }
            const float scl = p.in[8][l * 256 + c];
            unsigned short* yc = (unsigned short*)YC + (size_t)(row0 + ts) * 256 + c;
#pragma unroll
            for (int o = 0; o < 32; ++o) yc[o * 256] = (unsigned short)(pk(acc[o] * scl, 0.f) & 0xffffu);
            __syncthreads();
        }
    }
}

__device__ __forceinline__ void attn_phase(const Params& p, LAS unsigned char* lds, const int tid, const int bid) {
    const int lane = tid & 63, wave = tid >> 6, m = lane & 15, g = lane >> 4;
    const bf16_t* QR = (const bf16_t*)(p.ws + OFF_QR); const bf16_t* KR = (const bf16_t*)(p.ws + OFF_KR); const bf16_t* VT = (const bf16_t*)(p.ws + OFF_VT);
    const float* kpart = (const float*)(p.ws + OFF_KPART);
    bf16_t* YA = (bf16_t*)(p.ws + OFF_YA);
    constexpr int KBUF = 32768, VBUF = 64 * 528, BUF = KBUF + VBUF;
    LAS float* kbl = (LAS float*)(lds + 2 * BUF);
    const float NEG = -__builtin_huge_valf();
    const float SC = 0.125f * 1.4426950408889634f;
    int koff[2][2];
#pragma unroll
    for (int T = 0; T < 2; ++T) { const int kl = 8 * (m >> 2) + (m & 3) + 4 * T, f = (kl & 3) | ((kl >> 1) & 4);
#pragma unroll
        for (int kk = 0; kk < 2; ++kk) koff[T][kk] = kl * 128 + (((4 * kk + g) ^ f) * 16); }
    const int voff = m * 528 + g * 16;
    for (int s = bid; s < 256; s += gridDim.x) {
        const int bh = s >> 2, kq = s & 3, b = bh >> 3, h = bh & 7;
#pragma unroll 1
        for (int ii = 0; ii < 4; ++ii) {
            const int hb = (ii == 0) ? 15 - kq : (ii == 1) ? 8 + kq : (ii == 2) ? 7 - kq : kq;
            const int j = hb >> 1, half = hb & 1;
            const int qpos = half * 128 + wave * 16 + m;
            const size_t qrow = (size_t)bh * SEQ + j * 256 + qpos;
            const bf16x8 qf0 = *(const bf16x8*)(QR + qrow * 64 + 8 * g), qf1 = *(const bf16x8*)(QR + qrow * 64 + 32 + 8 * g);
            { const int n = tid >> 6, d = tid & 63;
              if (n < j) { const float* kp = kpart + (size_t)(b * 32 + n * 4) * 512 + h * 64 + d; kbl[n * 64 + d] = ((kp[0] + kp[512]) + (kp[1024] + kp[1536])) * (1.0f / 256.0f); } }
            const bf16_t* kbase = KR + (size_t)bh * SEQ * 64;
            const bf16_t* vbase = VT + (size_t)bh * 64 * SEQ;
            u32x4 kreg[4], vreg[4];
#pragma unroll
            for (int i = 0; i < 4; ++i) { const int idx = tid + 512 * i;
                kreg[i] = *(const u32x4*)(kbase + (size_t)j * 16384 + idx * 8);
                vreg[i] = *(const u32x4*)(vbase + (size_t)(idx >> 5) * SEQ + j * 256 + (idx & 31) * 8); }
#pragma unroll
            for (int i = 0; i < 4; ++i) { const int idx = tid + 512 * i, key = idx >> 3, ch = idx & 7, f = (key & 3) | ((key >> 1) & 4);
                *(LAS u32x4*)(lds + key * 128 + ((ch ^ f) * 16)) = kreg[i];
                *(LAS u32x4*)(lds + KBUF + (idx >> 5) * 528 + (idx & 31) * 16) = vreg[i]; }
            __syncthreads();
            unsigned selmask;
            if (j <= 3) selmask = (1u << j) - 1u;
            else {
                float qv[16];
                { const u32x4 a = __builtin_bit_cast(u32x4, qf0), c2 = __builtin_bit_cast(u32x4, qf1);
                  qv[0] = bf_lo(a.x); qv[1] = bf_hi(a.x); qv[2] = bf_lo(a.y); qv[3] = bf_hi(a.y); qv[4] = bf_lo(a.z); qv[5] = bf_hi(a.z); qv[6] = bf_lo(a.w); qv[7] = bf_hi(a.w);
                  qv[8] = bf_lo(c2.x); qv[9] = bf_hi(c2.x); qv[10] = bf_lo(c2.y); qv[11] = bf_hi(c2.y); qv[12] = bf_lo(c2.z); qv[13] = bf_hi(c2.z); qv[14] = bf_lo(c2.w); qv[15] = bf_hi(c2.w); }
                float sc[7];
#pragma unroll
                for (int n = 0; n < 7; ++n) { float part = 0.f;
                    if (n < j) {
#pragma unroll
                        for (int e = 0; e < 8; ++e) part += qv[e] * kbl[n * 64 + 8 * g + e] + qv[8 + e] * kbl[n * 64 + 32 + 8 * g + e];
                        part += __shfl_xor(part, 16); part += __shfl_xor(part, 32); }
                    sc[n] = (n < j) ? part : NEG; }
                selmask = 0u;
#pragma unroll
                for (int r = 0; r < 3; ++r) { float best = NEG; unsigned bi = 0u;
#pragma unroll
                    for (int n = 0; n < 7; ++n) { const bool take = (((selmask >> n) & 1u) == 0u) && (sc[n] > best); best = take ? sc[n] : best; bi = take ? (unsigned)n : bi; }
                    selmask |= 1u << bi; }
            }
            f32x4 O[4];
#pragma unroll
            for (int dt = 0; dt < 4; ++dt) O[dt] = (f32x4){0.f, 0.f, 0.f, 0.f};
            float m_run = NEG, l_run = 0.f;
#pragma unroll 1
            for (int it = 0; it <= j; ++it) {
                const int blk = (it == 0) ? j : it - 1;
                const bool more = (it + 1 <= j);
                if (more) {
#pragma unroll
                    for (int i = 0; i < 4; ++i) { const int idx = tid + 512 * i;
                        kreg[i] = *(const u32x4*)(kbase + (size_t)it * 16384 + idx * 8);
                        vreg[i] = *(const u32x4*)(vbase + (size_t)(idx >> 5) * SEQ + it * 256 + (idx & 31) * 8); } }
                const bool own = (it == 0);
                const bool sel = own || (((selmask >> blk) & 1u) != 0u);
                int nch;
                if (own) nch = ((half * 128 + wave * 16 + 15) >> 5) + 1; else nch = (__ballot(sel) != 0ull) ? 8 : 0;
                LAS unsigned char* kb_l = lds + (it & 1) * BUF; LAS unsigned char* vb_l = kb_l + KBUF;
#pragma unroll 1
                for (int c = 0; c < nch; ++c) {
                    f32x4 S0 = {0.f, 0.f, 0.f, 0.f}, S1 = {0.f, 0.f, 0.f, 0.f};
                    { const bf16x8 k00 = *(LAS const bf16x8*)(kb_l + c * 4096 + koff[0][0]), k01 = *(LAS const bf16x8*)(kb_l + c * 4096 + koff[0][1]);
                      const bf16x8 k10 = *(LAS const bf16x8*)(kb_l + c * 4096 + koff[1][0]), k11 = *(LAS const bf16x8*)(kb_l + c * 4096 + koff[1][1]);
                      S0 = __builtin_amdgcn_mfma_f32_16x16x32_bf16(k00, qf0, S0, 0, 0, 0); S0 = __builtin_amdgcn_mfma_f32_16x16x32_bf16(k01, qf1, S0, 0, 0, 0);
                      S1 = __builtin_amdgcn_mfma_f32_16x16x32_bf16(k10, qf0, S1, 0, 0, 0); S1 = __builtin_amdgcn_mfma_f32_16x16x32_bf16(k11, qf1, S1, 0, 0, 0); }
                    float sv[8];
#pragma unroll
                    for (int r = 0; r < 4; ++r) { sv[r] = S0[r] * SC; sv[4 + r] = S1[r] * SC; }
                    if (own) { const int kp0 = c * 32 + 8 * g;
#pragma unroll
                        for (int e = 0; e < 8; ++e) sv[e] = (kp0 + e <= qpos) ? sv[e] : NEG; }
                    else if (!sel) {
#pragma unroll
                        for (int e = 0; e < 8; ++e) sv[e] = NEG; }
                    float mx = fmaxf(fmaxf(fmaxf(sv[0], sv[1]), fmaxf(sv[2], sv[3])), fmaxf(fmaxf(sv[4], sv[5]), fmaxf(sv[6], sv[7])));
                    mx = fmaxf(mx, __shfl_xor(mx, 16)); mx = fmaxf(mx, __shfl_xor(mx, 32));
                    const float mn = fmaxf(m_run, mx);
                    const float al = __builtin_amdgcn_exp2f(m_run - mn);
                    float ps = 0.f;
#pragma unroll
                    for (int e = 0; e < 8; ++e) { sv[e] = __builtin_amdgcn_exp2f(sv[e] - mn); ps += sv[e]; }
                    l_run = l_run * al + ps; m_run = mn;
                    u32x4 pw; pw.x = pk(sv[0], sv[1]); pw.y = pk(sv[2], sv[3]); pw.z = pk(sv[4], sv[5]); pw.w = pk(sv[6], sv[7]);
                    const bf16x8 pf = __builtin_bit_cast(bf16x8, pw);
#pragma unroll
                    for (int dt = 0; dt < 4; ++dt) { const bf16x8 vf = *(LAS const bf16x8*)(vb_l + dt * (16 * 528) + voff + c * 64);
                        O[dt] = O[dt] * al; O[dt] = __builtin_amdgcn_mfma_f32_16x16x32_bf16(vf, pf, O[dt], 0, 0, 0); }
                }
                if (more) { LAS unsigned char* nb_l = lds + ((it + 1) & 1) * BUF;
#pragma unroll
                    for (int i = 0; i < 4; ++i) { const int idx = tid + 512 * i, key = idx >> 3, ch = idx & 7, f = (key & 3) | ((key >> 1) & 4);
                        *(LAS u32x4*)(nb_l + key * 128 + ((ch ^ f) * 16)) = kreg[i];
                        *(LAS u32x4*)(nb_l + KBUF + (idx >> 5) * 528 + (idx & 31) * 16) = vreg[i]; } }
                __syncthreads();
            }
            float lt = l_run; lt += __shfl_xor(lt, 16); lt += __shfl_xor(lt, 32);
            const float inv = 1.0f / lt;
            bf16_t* yo = YA + ((size_t)b * SEQ + j * 256 + qpos) * 512 + h * 64 + 4 * g;
#pragma unroll
            for (int dt = 0; dt < 4; ++dt) { u32x2 w; w.x = pk(O[dt][0] * inv, O[dt][1] * inv); w.y = pk(O[dt][2] * inv, O[dt][3] * inv); *(u32x2*)(yo + 16 * dt) = w; }
        }
    }
}

__global__ void __launch_bounds__(512, 2) mega_fwd(Params p_arg) {
    extern __shared__ __attribute__((aligned(16))) unsigned char smem[];
    LAS unsigned char* lds = (LAS unsigned char*)smem;
    const int ph_lo = p_arg.ph_lo, ph_hi = p_arg.ph_hi;
    const int wave_s = __builtin_amdgcn_readfirstlane((int)threadIdx.x >> 6);
#pragma unroll 1
    for (int ph = ph_lo; ph < ph_hi; ++ph) {
        typedef const __attribute__((address_space(4))) Params* CParamsPtr;
        CParamsPtr pp = (CParamsPtr)__builtin_amdgcn_kernarg_segment_ptr(); asm volatile("" : "+s"(pp));
        Params p;
#pragma unroll
        for (int i = 0; i < 21; ++i) p.in[i] = pp->in[i];
        p.out = pp->out; p.ws = pp->ws; p.ph_lo = 0; p.ph_hi = 0;
        unsigned zr = 0u; asm volatile("" : "+v"(zr)); int tid = wave_s * 64 + (int)__builtin_amdgcn_mbcnt_hi(~0u, __builtin_amdgcn_mbcnt_lo(~0u, zr));
        int bid = blockIdx.x; asm volatile("" : "+s"(bid));
        bf16_t* WT = (bf16_t*)(p.ws + OFF_WT);
        bf16_t* XN = (bf16_t*)(p.ws + OFF_XN); bf16_t* Z = (bf16_t*)(p.ws + OFF_Z); bf16_t* H = (bf16_t*)(p.ws + OFF_H); bf16_t* MIX = (bf16_t*)(p.ws + OFF_MIX);
        float* X1 = (float*)(p.ws + OFF_X1);
        if (ph == 0) { if (EN(9)) phase0(p, lds, tid, bid); }
        else {
            const int l = (ph - 1) / 9, k = (ph - 1) % 9;
            if (k == 0 && EN(0)) {
                pg8::Gemm gm{XN, WT + WT_IN, M_TOK, INW, DM}; pg8::StaticOrder S; S.init(M_TOK, INW, (int)gridDim.x, bid);
                pg8::EpiBf16<0> E{Z, INW, p.in[2] + (size_t)l * INW, 0, 0};
                pg8::gemm_phase<pg8::EpiBf16<0>, pg8::StaticOrder, false>(lds, gm, S, E, nullptr, tid);
            } else if (k == 1 && EN(1)) mixers_phase(p, l, lds, tid, bid);
            else if (k == 2 && EN(2)) attn_phase(p, lds, tid, bid);
            else if (k == 3 && EN(3)) {
#pragma unroll 1
                for (int br = 0; br < 4; ++br) {
                    unsigned zr2 = 0u; asm volatile("" : "+v"(zr2)); int tid2 = wave_s * 64 + (int)__builtin_amdgcn_mbcnt_hi(~0u, __builtin_amdgcn_mbcnt_lo(~0u, zr2));
                    int bid2 = blockIdx.x; asm volatile("" : "+s"(bid2));
                    pg8::StaticOrder S; S.init(M_TOK, DM, (int)gridDim.x, bid2);
                    pg8::Gemm gm{(const bf16_t*)(p.ws + (br == 0 ? OFF_YA : OFF_YB + (size_t)(br - 1) * 8388608)), WT + (br == 0 ? WT_PA : WT_PB + (size_t)(br - 1) * 262144), M_TOK, DM, br == 0 ? 512 : 256};
                    EpiGate E{Z + 3072 + br * 1024, MIX, br == 0 ? 1 : 0}; pg8::gemm_phase<EpiGate, pg8::StaticOrder, false>(lds, gm, S, E, nullptr, tid2); }
            } else if ((k == 4 || k == 7) && EN(4)) {
                pg8::Gemm gm{k == 4 ? MIX : H, WT + (k == 4 ? WT_O : WT_M2), M_TOK, DM, k == 4 ? DM : DFF}; pg8::StaticOrder S; S.init(M_TOK, DM, (int)gridDim.x, bid);
                EpiRes E{k == 4 ? (l == 0 ? p.in[0] : (const float*)p.out) : (const float*)X1, k == 4 ? X1 : p.out}; pg8::gemm_phase<EpiRes, pg8::StaticOrder, false>(lds, gm, S, E, nullptr, tid);
            } else if (k == 5 && EN(5)) ln_phase(X1, p.in[15] + l * DM, p.in[16] + l * DM, XN, tid, bid);
            else if (k == 6 && EN(6)) {
                pg8::Gemm gm{XN, WT + WT_M1, M_TOK, DFF, DM}; pg8::StaticOrder S; S.init(M_TOK, DFF, (int)gridDim.x, bid);
                EpiRelu2 E{H, DFF}; pg8::gemm_phase<EpiRelu2, pg8::StaticOrder, false>(lds, gm, S, E, nullptr, tid);
            } else if (k == 8 && EN(8)) {
                ln_phase(p.out, p.in[19] + l * DM, p.in[20] + l * DM, XN, tid, bid);
                if (l + 1 < DEPTH) convert_layer(p, l + 1, lds, tid, bid);
            }
        }
        if (ph + 1 < ph_hi) { __syncthreads(); cg::this_grid().sync(); }
    }
}

extern "C" void kernel_launch(void* const* d_in, const int* in_sizes, int n_in, void* d_out, int out_size, void* d_ws, size_t ws_size, hipStream_t stream) {
    static int grid = 0;
    if (grid == 0) {
        if (n_in != 21 || ws_size < WS_END) { fprintf(stderr, "kernel_launch: unexpected n_in %d or ws_size %zu (< %zu)\n", n_in, ws_size, (size_t)WS_END); grid = -1; return; }
        if (hipFuncSetAttribute((const void*)mega_fwd, hipFuncAttributeMaxDynamicSharedMemorySize, LDS_BYTES) != hipSuccess) { fprintf(stderr, "kernel_launch: hipFuncSetAttribute failed\n"); grid = -1; return; }
        int dev = 0, cus = 0, per_cu = 0;
        (void)hipGetDevice(&dev); (void)hipDeviceGetAttribute(&cus, hipDeviceAttributeMultiprocessorCount, dev);
        (void)hipOccupancyMaxActiveBlocksPerMultiprocessor(&per_cu, (const void*)mega_fwd, 512, LDS_BYTES);
        if (per_cu < 1) { fprintf(stderr, "kernel_launch: occupancy query says %d blocks per CU\n", per_cu); per_cu = 1; }
        (void)hipGetLastError();
        grid = cus * 1;
        if (grid > 256) grid = 256;
    }
    if (grid < 0) return;
    Params p{};
    for (int i = 0; i < 21; ++i) p.in[i] = (const float*)d_in[i];
    p.out = (float*)d_out; p.ws = (unsigned char*)d_ws;
#if MK_COOP
    p.ph_lo = 0; p.ph_hi = NPHASE;
    void* args[] = {&p};
    hipError_t e = hipLaunchCooperativeKernel((const void*)mega_fwd, dim3(grid), dim3(512), args, LDS_BYTES, stream);
    if (e != hipSuccess) fprintf(stderr, "cooperative launch failed: %s (grid %d)\n", hipGetErrorString(e), grid);
#else
    for (int ph = 0; ph < NPHASE; ++ph) { p.ph_lo = ph; p.ph_hi = ph + 1; hipLaunchKernelGGL(mega_fwd, dim3(grid), dim3(512), LDS_BYTES, stream, p); }
#endif
}
```

```cpp
#include <hip/hip_runtime.h>
#include <hip/hip_cooperative_groups.h>
#include <cstdio>
#include <cmath>
namespace cg = cooperative_groups;
namespace pg8 {
#define PG8_LAS __attribute__((address_space(3)))
typedef unsigned short bf16_t;
typedef short bf16x8 __attribute__((ext_vector_type(8)));
typedef float f32x4 __attribute__((ext_vector_type(4)));
typedef unsigned u32x4 __attribute__((ext_vector_type(4)));
constexpr int BM = 256, BK = 64, HALF = 128, HTB = HALF * BK * 2  , STAGE_BYTES = 8 * HTB, NXCD = 8, WGM = 8;

__host__ __device__ __forceinline__ int lds_byte(int r, int c) { const int st = (r >> 4) * 2 + (c >> 5), rr = r & 15, cc = c & 31, ob = rr * 64 + cc * 2; return st * 1024 + (ob ^ (((ob >> 9) & 1) << 5)); }
__host__ __device__ __forceinline__ void stage_rc(int b, int& R, int& C) { const int st = b / 1024, sb = b % 1024, swz = sb ^ (((sb >> 9) & 1) << 5); R = (st >> 1) * 16 + swz / 64; C = (st & 1) * 32 + (swz % 64) / 2; }
__host__ __device__ __forceinline__ int perm32(int rho) { const int n = rho >> 4, i = rho & 15; return 8 * (i >> 2) + 4 * n + (i & 3); }

struct Unit { int pm, pn; };
struct Gemm { const bf16_t* A; const bf16_t* Bt; int M, N, K; };

struct StaticOrder {
    int nM, nN, nwg, G, c;
    __host__ __device__ void init(int M, int N, int G_, int c_) { nM = M / BM; nN = N / BM; nwg = nM * nN; G = G_; c = c_; }
    __host__ __device__ bool next(int i, Unit& u) const {
        const long L = (long)i * G + c; if (L >= nwg) return false;
        int wgid = (int)L; { const int q = nwg / NXCD, r = nwg % NXCD, xcd = wgid % NXCD, off = wgid / NXCD; wgid = (xcd < r ? xcd * (q + 1) : r * (q + 1) + (xcd - r) * q) + off; }
        const int nig = WGM * nN, gid = wgid / nig, fm = gid * WGM, gsz = (nM - fm) < WGM ? (nM - fm) : WGM;
        u.pm = fm + ((wgid % nig) % gsz); u.pn = (wgid % nig) / gsz; return true;
    }
    __device__ __forceinline__ void a_ready(const Unit&) const {}
    __device__ __forceinline__ void done(const Unit&) const {}
};
struct CountedOrder : StaticOrder {
    const unsigned* ready; unsigned need; unsigned* tmo;
    __device__ __forceinline__ void a_ready(const Unit& u) const {
        if (threadIdx.x < 64) {
            const unsigned long long t0 = __builtin_amdgcn_s_memrealtime(); unsigned polls = 0;
            while ((unsigned)__builtin_amdgcn_readfirstlane(__hip_atomic_load(ready + 64 * u.pm, __ATOMIC_RELAXED, __HIP_MEMORY_SCOPE_AGENT)) < need) {
                if ((++polls & 255u) == 0u && __builtin_amdgcn_readfirstlane(__hip_atomic_load(tmo, __ATOMIC_RELAXED, __HIP_MEMORY_SCOPE_AGENT)) != 0u) break;
                if (__builtin_amdgcn_s_memrealtime() - t0 > 2000000ull) {
                    if (threadIdx.x == 0) { unsigned expect = 0u; __hip_atomic_compare_exchange_strong(tmo + 1, &expect, 0x600u | (unsigned)(u.pm & 0xff), __ATOMIC_RELAXED, __ATOMIC_RELAXED, __HIP_MEMORY_SCOPE_AGENT); __hip_atomic_store(tmo, 1u, __ATOMIC_RELAXED, __HIP_MEMORY_SCOPE_AGENT); }
                    break; }
                __builtin_amdgcn_s_sleep(2); }
            __builtin_amdgcn_fence(__ATOMIC_ACQUIRE, "agent");
            asm volatile("s_waitcnt vmcnt(0)" ::: "memory");
        }
#if !defined(BROKEN_HOOK_NO_BARRIER)
        asm volatile("" ::: "memory"); __builtin_amdgcn_s_barrier(); asm volatile("" ::: "memory");
#endif
    }
};

__device__ __forceinline__ unsigned cvt_pk_bf16(float lo, float hi) { unsigned r; asm volatile("v_cvt_pk_bf16_f32 %0, %1, %2" : "=v"(r) : "v"(lo), "v"(hi)); return r; }
typedef float f32x2 __attribute__((ext_vector_type(2)));
__device__ __forceinline__ f32x2 gelu_pk(f32x2 v) {
    const f32x2 av = __builtin_elementwise_abs(v), d = av * 0.2316418882f + 1.0f;
    f32x2 t; t.x = __builtin_amdgcn_rcpf(d.x); t.y = __builtin_amdgcn_rcpf(d.y);
    f32x2 q = t * 0.5307027145f + (-0.7265760135f); q = q * t + 0.7107068705f; q = q * t + (-0.142248368f); q = q * t + 0.127414796f; q = q * t;
    const f32x2 s = (v * v) * (-0.72134752044f);
    f32x2 e; e.x = __builtin_amdgcn_exp2f(s.x); e.y = __builtin_amdgcn_exp2f(s.y);
    const f32x2 m = v * (q * e), r = v - m;
    f32x2 o; o.x = v.x < 0.f ? m.x : r.x; o.y = v.y < 0.f ? m.y : r.y; return o;
}

struct EpiF32 {
    static constexpr bool PERM = false, AFTER_DRAIN = false;
    float* C; int ldc; const float* bias;
    __device__ __forceinline__ void operator()(const f32x4 (&acc)[2][2][4][2], const Unit& u, int wr, int wc, int fr, int fq) const {
        const int row0 = u.pm * BM + wr * 64 + fr, col0 = u.pn * BM + wc * 32 + 4 * fq;
        f32x4 bv[2][2];
#pragma unroll
        for (int bj = 0; bj < 2; ++bj)
#pragma unroll
            for (int n = 0; n < 2; ++n) bv[bj][n] = bias ? *(const f32x4*)(bias + col0 + bj * HALF + n * 16) : (f32x4){0.f, 0.f, 0.f, 0.f};
#pragma unroll
        for (int ai = 0; ai < 2; ++ai)
#pragma unroll
            for (int m = 0; m < 4; ++m) { float* rowp = C + (size_t)(row0 + ai * HALF + m * 16) * ldc + col0;
#pragma unroll
                for (int bj = 0; bj < 2; ++bj)
#pragma unroll
                    for (int n = 0; n < 2; ++n) *(f32x4*)(rowp + bj * HALF + n * 16) = acc[ai][bj][m][n] + bv[bj][n]; }
    }
};
template <int ACT  > struct EpiBf16 {
    static constexpr bool PERM = true, AFTER_DRAIN = false;
    bf16_t* O; int ldc; const float* bias; int split_cols; size_t split_stride;
    __device__ __forceinline__ void operator()(const f32x4 (&acc)[2][2][4][2], const Unit& u, int wr, int wc, int fr, int fq) const {
        const int row0 = u.pm * BM + wr * 64 + fr; int colt = u.pn * BM; bf16_t* base = O;
        if (split_cols) { const int t = colt / split_cols; base += (size_t)t * split_stride; colt -= t * split_cols; }
        const int col0 = colt + wc * 32 + 8 * fq, bcol0 = u.pn * BM + wc * 32 + 8 * fq;
        f32x4 bv[2][2];
#pragma unroll
        for (int bj = 0; bj < 2; ++bj)
#pragma unroll
            for (int n = 0; n < 2; ++n) bv[bj][n] = bias ? *(const f32x4*)(bias + bcol0 + bj * HALF + 4 * n) : (f32x4){0.f, 0.f, 0.f, 0.f};
#pragma unroll
        for (int ai = 0; ai < 2; ++ai)
#pragma unroll
            for (int m = 0; m < 4; ++m) { bf16_t* rowp = base + (size_t)(row0 + ai * HALF + m * 16) * ldc + col0;
#pragma unroll
                for (int bj = 0; bj < 2; ++bj) { f32x4 v0 = acc[ai][bj][m][0] + bv[bj][0], v1 = acc[ai][bj][m][1] + bv[bj][1];
                    if (ACT == 1) { f32x2 a = gelu_pk((f32x2){v0[0], v0[1]}), b = gelu_pk((f32x2){v0[2], v0[3]}), c = gelu_pk((f32x2){v1[0], v1[1]}), d = gelu_pk((f32x2){v1[2], v1[3]});
                        v0 = (f32x4){a.x, a.y, b.x, b.y}; v1 = (f32x4){c.x, c.y, d.x, d.y}; }
                    if (ACT == 2) {
#pragma unroll
                        for (int j = 0; j < 4; ++j) { v0[j] = 0.5f * v0[j] * (1.0f + erff(v0[j] * 0.70710678f)); v1[j] = 0.5f * v1[j] * (1.0f + erff(v1[j] * 0.70710678f)); } }
                    u32x4 w; w.x = cvt_pk_bf16(v0[0], v0[1]); w.y = cvt_pk_bf16(v0[2], v0[3]); w.z = cvt_pk_bf16(v1[0], v1[1]); w.w = cvt_pk_bf16(v1[2], v1[3]);
                    *(u32x4*)(rowp + bj * HALF) = w; } }
    }
};

struct PanelStats {
    unsigned* xbuf;
    unsigned* cnt;
    unsigned* tmo;
    int ntn; float eps;
    unsigned code;
    __device__ __forceinline__ bool run(const f32x4 (&v)[2][2][4][2], const Unit& u, int wr, int wc, int fr, int fq, PG8_LAS unsigned char* lds, int wid, int lane) const {
        typedef float f32x2v __attribute__((ext_vector_type(2)));
        PG8_LAS f32x2v* P = (PG8_LAS f32x2v*)lds;
        PG8_LAS f32x2v* S = (PG8_LAS f32x2v*)(lds + 8192);
        PG8_LAS unsigned* flag = (PG8_LAS unsigned*)(lds + 8192 + 2048);
#pragma unroll
        for (int ai = 0; ai < 2; ++ai)
#pragma unroll
            for (int m = 0; m < 4; ++m) {
                float s = 0.f;
#pragma unroll
                for (int bj = 0; bj < 2; ++bj)
#pragma unroll
                    for (int n = 0; n < 2; ++n) { const f32x4 x = v[ai][bj][m][n]; s += (x[0] + x[1]) + (x[2] + x[3]); }
                s += __shfl_xor(s, 16); s += __shfl_xor(s, 32);
                const float mw = s * (1.0f / 64.0f); float q = 0.f;
#pragma unroll
                for (int bj = 0; bj < 2; ++bj)
#pragma unroll
                    for (int n = 0; n < 2; ++n) { const f32x4 d = v[ai][bj][m][n] - mw; q += (d[0] * d[0] + d[1] * d[1]) + (d[2] * d[2] + d[3] * d[3]); }
                q += __shfl_xor(q, 16); q += __shfl_xor(q, 32);
                if (fq == 0) P[(ai * HALF + wr * 64 + m * 16 + fr) * 4 + wc] = (f32x2v){mw, q};
            }
        asm volatile("s_waitcnt lgkmcnt(0)" ::: "memory"); __builtin_amdgcn_s_barrier(); asm volatile("" ::: "memory");
#if defined(BROKEN_NO_WAIT)
        if (blockIdx.x >= 64) { const long long t0 = clock64(); while (clock64() - t0 < 60000) __builtin_amdgcn_s_sleep(8); }
#endif
        const int row = wid * 32 + (lane & 31);
        if (lane < 32) {
            const f32x2v a = P[row * 4 + 0], b = P[row * 4 + 1], c = P[row * 4 + 2], d = P[row * 4 + 3];
            const float mt = (a.x + b.x + c.x + d.x) * 0.25f;
            const float da = a.x - mt, db = b.x - mt, dc = c.x - mt, dd = d.x - mt;
            const float m2 = (a.y + b.y) + (c.y + d.y) + 64.0f * ((da * da + db * db) + (dc * dc + dd * dd));
            unsigned long long* slot = (unsigned long long*)xbuf + ((size_t)(u.pm * BM + row) * 4 + u.pn);
            __hip_atomic_store(slot, ((unsigned long long)__float_as_uint(m2) << 32) | __float_as_uint(mt), __ATOMIC_RELAXED, __HIP_MEMORY_SCOPE_AGENT);
        }
        asm volatile("s_waitcnt vmcnt(0)" ::: "memory");
        if (lane == 0) __hip_atomic_fetch_add(cnt + 64 * u.pm, 1u, __ATOMIC_RELAXED, __HIP_MEMORY_SCOPE_AGENT);
        if (wid == 0) {
            bool dead = false; const unsigned long long t0 = __builtin_amdgcn_s_memrealtime(); const unsigned want = 8u * (unsigned)ntn;
            for (;;) {
#if defined(BROKEN_NO_WAIT)
                break;
#endif
                if ((unsigned)__builtin_amdgcn_readfirstlane(__hip_atomic_load(cnt + 64 * u.pm, __ATOMIC_RELAXED, __HIP_MEMORY_SCOPE_AGENT)) >= want) break;
                if (__builtin_amdgcn_s_memrealtime() - t0 > 2000000ull) {
                    if (lane == 0) { unsigned expect = 0u; __hip_atomic_compare_exchange_strong(tmo + 1, &expect, code | (unsigned)(u.pm & 0xff), __ATOMIC_RELAXED, __ATOMIC_RELAXED, __HIP_MEMORY_SCOPE_AGENT);
                                     __hip_atomic_store(tmo, 1u, __ATOMIC_RELAXED, __HIP_MEMORY_SCOPE_AGENT); }
                    dead = true; break; }
                __builtin_amdgcn_s_sleep(2);
            }
            __builtin_amdgcn_fence(__ATOMIC_ACQUIRE, "agent");
            if (lane == 0) flag[0] = dead ? 1u : 0u;
        }
        asm volatile("s_waitcnt vmcnt(0) lgkmcnt(0)" ::: "memory"); __builtin_amdgcn_s_barrier(); asm volatile("" ::: "memory");
        const bool bad = flag[0] != 0u;
        if (lane < 32) {
            const unsigned long long* slot = (const unsigned long long*)xbuf + (size_t)(u.pm * BM + row) * 4; float mt[4], m2[4]; float ms = 0.f;
#pragma unroll
            for (int t = 0; t < 4; ++t) { if (t < ntn) { const unsigned long long w = __hip_atomic_load(slot + t, __ATOMIC_RELAXED, __HIP_MEMORY_SCOPE_AGENT); mt[t] = __uint_as_float((unsigned)w); m2[t] = __uint_as_float((unsigned)(w >> 32)); } else { mt[t] = 0.f; m2[t] = 0.f; } ms += mt[t]; }
            const float mean = ms / (float)ntn; float q = 0.f;
#pragma unroll
            for (int t = 0; t < 4; ++t) if (t < ntn) { const float dm = mt[t] - mean; q += m2[t] + 256.0f * dm * dm; }
            S[row] = (f32x2v){mean, 1.0f / sqrtf(q / (256.0f * (float)ntn) + eps)};
        }
        asm volatile("s_waitcnt lgkmcnt(0)" ::: "memory"); __builtin_amdgcn_s_barrier(); asm volatile("" ::: "memory");
        return bad;
    }
};
struct EpiLnRes {
    static constexpr bool PERM = false, AFTER_DRAIN = true;
    const float* base; float* out; int ldc; const float* bias; PanelStats st; unsigned poison;
    __device__ __forceinline__ void refuse(size_t i0, size_t stride, int M, int N) const { const float q = __builtin_nanf(""); for (size_t i = i0; i < (size_t)M * N; i += stride) out[(i / N) * ldc + i % N] = q;
        if (i0 == 0) { unsigned expect = 0u; __hip_atomic_compare_exchange_strong(st.tmo + 1, &expect, 0x7f0u, __ATOMIC_RELAXED, __ATOMIC_RELAXED, __HIP_MEMORY_SCOPE_AGENT); __hip_atomic_store(st.tmo, 1u, __ATOMIC_RELAXED, __HIP_MEMORY_SCOPE_AGENT); } }
    __device__ __forceinline__ void fused(f32x4 (&acc)[2][2][4][2], const Unit& u, int wr, int wc, int fr, int fq, PG8_LAS unsigned char* lds, int wid, int lane) const {
        typedef float f32x2v __attribute__((ext_vector_type(2)));
        const PG8_LAS f32x2v* S = (const PG8_LAS f32x2v*)(lds + 8192);
        const int col0 = u.pn * BM + wc * 32 + 4 * fq;
#pragma unroll
        for (int bj = 0; bj < 2; ++bj)
#pragma unroll
            for (int n = 0; n < 2; ++n) { const f32x4 bv = bias ? *(const f32x4*)(bias + col0 + bj * HALF + n * 16) : (f32x4){0.f, 0.f, 0.f, 0.f};
#pragma unroll
                for (int ai = 0; ai < 2; ++ai)
#pragma unroll
                    for (int m = 0; m < 4; ++m) acc[ai][bj][m][n] += bv; }
        const bool bad = st.run(acc, u, wr, wc, fr, fq, lds, wid, lane) || poison != 0u;
        const float qnan = __builtin_nanf("");
#pragma unroll
        for (int ai = 0; ai < 2; ++ai)
#pragma unroll
            for (int m = 0; m < 4; ++m) { const int r = ai * HALF + wr * 64 + m * 16 + fr; const f32x2v sr = S[r]; const size_t off = (size_t)(u.pm * BM + r) * ldc + col0;
#pragma unroll
                for (int bj = 0; bj < 2; ++bj)
#pragma unroll
                    for (int n = 0; n < 2; ++n) { const f32x4 bs = *(const f32x4*)(base + off + bj * HALF + n * 16); f32x4 o = bs + (acc[ai][bj][m][n] - sr.x) * sr.y;
                        if (bad) o = (f32x4){qnan, qnan, qnan, qnan}; *(f32x4*)(out + off + bj * HALF + n * 16) = o; }
                asm volatile("" ::: "memory"); }
    }
};
struct EpiLnResLn {
    static constexpr bool PERM = false, AFTER_DRAIN = true;
    const float* base; float* out; bf16_t* xn; int ldc; const float* bias; PanelStats st1, st2; unsigned poison;
    __device__ __forceinline__ void refuse(size_t i0, size_t stride, int M, int N) const { const float q = __builtin_nanf(""); for (size_t i = i0; i < (size_t)M * N; i += stride) { const size_t o = (i / N) * ldc + i % N; out[o] = q; xn[o] = (bf16_t)0x7fc0u; }
        if (i0 == 0) { unsigned expect = 0u; __hip_atomic_compare_exchange_strong(st1.tmo + 1, &expect, 0x7f0u, __ATOMIC_RELAXED, __ATOMIC_RELAXED, __HIP_MEMORY_SCOPE_AGENT); __hip_atomic_store(st1.tmo, 1u, __ATOMIC_RELAXED, __HIP_MEMORY_SCOPE_AGENT); } }
    __device__ __forceinline__ void fused(f32x4 (&acc)[2][2][4][2], const Unit& u, int wr, int wc, int fr, int fq, PG8_LAS unsigned char* lds, int wid, int lane) const {
        typedef float f32x2v __attribute__((ext_vector_type(2))); typedef unsigned u32x2v __attribute__((ext_vector_type(2)));
        const PG8_LAS f32x2v* S = (const PG8_LAS f32x2v*)(lds + 8192);
        const int col0 = u.pn * BM + wc * 32 + 4 * fq;
#pragma unroll
        for (int bj = 0; bj < 2; ++bj)
#pragma unroll
            for (int n = 0; n < 2; ++n) { const f32x4 bv = bias ? *(const f32x4*)(bias + col0 + bj * HALF + n * 16) : (f32x4){0.f, 0.f, 0.f, 0.f};
#pragma unroll
                for (int ai = 0; ai < 2; ++ai)
#pragma unroll
                    for (int m = 0; m < 4; ++m) acc[ai][bj][m][n] += bv; }
        bool bad = st1.run(acc, u, wr, wc, fr, fq, lds, wid, lane) || poison != 0u;
        const float qnan = __builtin_nanf("");
#pragma unroll
        for (int ai = 0; ai < 2; ++ai)
#pragma unroll
            for (int m = 0; m < 4; ++m) { const int r = ai * HALF + wr * 64 + m * 16 + fr; const f32x2v sr = S[r]; const size_t off = (size_t)(u.pm * BM + r) * ldc + col0;
#pragma unroll
                for (int bj = 0; bj < 2; ++bj)
#pragma unroll
                    for (int n = 0; n < 2; ++n) { const f32x4 bs = *(const f32x4*)(base + off + bj * HALF + n * 16); acc[ai][bj][m][n] = bs + (acc[ai][bj][m][n] - sr.x) * sr.y; }
                asm volatile("" : "+v"(acc[ai][0][m][0]), "+v"(acc[ai][0][m][1]), "+v"(acc[ai][1][m][0]), "+v"(acc[ai][1][m][1]));
                if (m & 1) asm volatile("" ::: "memory"); }
        const bool bad1 = bad;
        bad = st2.run(acc, u, wr, wc, fr, fq, lds, wid, lane) || bad;
#pragma unroll
        for (int ai = 0; ai < 2; ++ai)
#pragma unroll
            for (int m = 0; m < 4; ++m) { const int r = ai * HALF + wr * 64 + m * 16 + fr; const f32x2v sr = S[r]; const size_t off = (size_t)(u.pm * BM + r) * ldc + col0;
#pragma unroll
                for (int bj = 0; bj < 2; ++bj)
#pragma unroll
                    for (int n = 0; n < 2; ++n) { const f32x4 x1 = acc[ai][bj][m][n]; *(f32x4*)(out + off + bj * HALF + n * 16) = bad1 ? (f32x4){qnan, qnan, qnan, qnan} : x1;
                        const f32x4 o = (x1 - sr.x) * sr.y; u32x2v w; w.x = cvt_pk_bf16(o[0], o[1]); w.y = cvt_pk_bf16(o[2], o[3]);
                        if (bad) { w.x = 0x7fc07fc0u; w.y = 0x7fc07fc0u; } *(u32x2v*)(xn + off + bj * HALF + n * 16) = w; }
                asm volatile("" ::: "memory"); }
    }
};

template <class Epi, class Sched, bool STAMP = false>
__device__ __forceinline__ void gemm_phase(PG8_LAS unsigned char* lds, const Gemm g, const Sched& S, const Epi& E, unsigned long long* stamps, const int tid_in) {
    const int tid = tid_in, wid = __builtin_amdgcn_readfirstlane(tid >> 6), lane = tid & 63, wr = wid >> 2, wc = wid & 3, fr = lane & 15, fq = lane >> 4;
    const int K = g.K, nt = K / BK;
    int ts_lo = 0, ts_hi = 0, nts = 0; const unsigned long long rt_entry = STAMP ? (unsigned long long)wall_clock64() : 0ull;
#define PG8_STAMP() do { if (STAMP && wid == 0 && nts < 64) { const unsigned long long _c = (unsigned long long)clock64(); \
        ts_lo = (lane == nts) ? (int)(unsigned)_c : ts_lo; ts_hi = (lane == nts) ? (int)(unsigned)(_c >> 32) : ts_hi; ++nts; } } while (0)
    PG8_STAMP();
    unsigned voffA[2], voffB[2];
#pragma unroll
    for (int i = 0; i < 2; ++i) { int R, C; stage_rc(tid * 16 + i * 8192, R, C); const int Rb = Epi::PERM ? ((R & ~31) + perm32(R & 31)) : R;
        voffA[i] = (unsigned)(R * K + C) * 2u; voffB[i] = (unsigned)(Rb * K + C) * 2u; }
    const size_t kstep = (size_t)(BK * 2);
    const size_t hstep = (size_t)HALF * K * 2;
    const size_t tstep = 2 * hstep;
    const unsigned ldsw = (unsigned)wid * 1024u;
    const int aoff = lds_byte(wr * 64 + fr, fq * 8), boff = lds_byte(wc * 32 + fr, fq * 8);
#define PG8_SA(b, h) (((b) * 2 + (h)) * HTB)
#define PG8_SB(b, h) ((4 + (b) * 2 + (h)) * HTB)
#define PG8_STAGE(bufoff, gbase, voff) do { _Pragma("unroll") for (int _i = 0; _i < 2; ++_i) \
        __builtin_amdgcn_global_load_lds((const unsigned*)((const char*)(gbase) + (voff)[_i]), (PG8_LAS unsigned*)(lds + (bufoff) + ldsw + _i * 8192), 16, 0, 0); } while (0)
#define PG8_LDA(dst, b, h) do { _Pragma("unroll") for (int m = 0; m < 4; ++m) _Pragma("unroll") for (int k = 0; k < 2; ++k) dst[m][k] = *(const PG8_LAS bf16x8*)(lds + PG8_SA(b, h) + aoff + m * 2048 + k * 1024); } while (0)
#define PG8_LDB(dst, b, h) do { _Pragma("unroll") for (int n = 0; n < 2; ++n) _Pragma("unroll") for (int k = 0; k < 2; ++k) dst[n][k] = *(const PG8_LAS bf16x8*)(lds + PG8_SB(b, h) + boff + n * 2048 + k * 1024); } while (0)
#define PG8_MMA(ai, bj, At, Bt) do { __builtin_amdgcn_s_setprio(1); _Pragma("unroll") for (int m = 0; m < 4; ++m) _Pragma("unroll") for (int n = 0; n < 2; ++n) _Pragma("unroll") for (int k = 0; k < 2; ++k) \
        acc[ai][bj][m][n] = __builtin_amdgcn_mfma_f32_16x16x32_bf16(Bt[n][k], At[m][k], acc[ai][bj][m][n], 0, 0, 0); __builtin_amdgcn_s_setprio(0); } while (0)
#define PG8_WAIT_V(n) asm volatile("s_waitcnt vmcnt(" #n ")" ::: "memory")
#define PG8_WAIT_L(n) asm volatile("s_waitcnt lgkmcnt(" #n ")" ::: "memory")
#define PG8_BAR __builtin_amdgcn_s_barrier()
#define PG8_SCHED __builtin_amdgcn_sched_barrier(0)
    Unit cur, nxt; int ui = 0;
    if (!S.next(0, cur)) return;
    f32x4 acc[2][2][4][2];
#pragma unroll
    for (int a = 0; a < 2; ++a)
#pragma unroll
        for (int b = 0; b < 2; ++b)
#pragma unroll
            for (int m = 0; m < 4; ++m)
#pragma unroll
                for (int n = 0; n < 2; ++n) acc[a][b][m][n] = (f32x4){0.f, 0.f, 0.f, 0.f};
    bf16x8 At[4][2], B0[2][2], B1[2][2];
    const char* cA = (const char*)g.A + (size_t)cur.pm * tstep; const char* cB = (const char*)g.Bt + (size_t)cur.pn * tstep;
    S.a_ready(cur);
    PG8_STAGE(PG8_SB(0, 0), cB, voffB); PG8_STAGE(PG8_SA(0, 0), cA, voffA); PG8_STAGE(PG8_SB(0, 1), cB + hstep, voffB); PG8_STAGE(PG8_SA(0, 1), cA + hstep, voffA);
    if (wr == 1) PG8_BAR;
    PG8_WAIT_V(4); PG8_BAR;
    PG8_STAGE(PG8_SB(1, 0), cB + kstep, voffB); PG8_STAGE(PG8_SA(1, 0), cA + kstep, voffA); PG8_STAGE(PG8_SB(1, 1), cB + hstep + kstep, voffB);
    PG8_WAIT_V(6); PG8_BAR;
    PG8_STAMP();
    for (;;) {
        const bool has_next = S.next(ui + 1, nxt);
        const char* nA = has_next ? (const char*)g.A + (size_t)nxt.pm * tstep : cA; const char* nB = has_next ? (const char*)g.Bt + (size_t)nxt.pn * tstep : cB;
        for (int t = 0; t < nt; t += 2) {
            const bool last = (t == nt - 2);
            const char* a1 = cA + (size_t)(t + 1) * kstep;
            const char* a2 = last ? nA : cA + (size_t)(t + 2) * kstep; const char* b2 = last ? nB : cB + (size_t)(t + 2) * kstep;
            const char* a3 = a2 + kstep; const char* b3 = b2 + kstep;
            if (last && has_next) S.a_ready(nxt);
            PG8_LDB(B0, 0, 0); PG8_SCHED; PG8_LDA(At, 0, 0); PG8_STAGE(PG8_SA(1, 1), a1 + hstep, voffA);
            PG8_WAIT_L(8); PG8_BAR; PG8_WAIT_L(0); PG8_MMA(0, 0, At, B0); PG8_BAR; PG8_SCHED;
            PG8_LDB(B1, 0, 1); PG8_STAGE(PG8_SB(0, 0), b2, voffB);
            PG8_BAR; PG8_WAIT_L(0); PG8_MMA(0, 1, At, B1); PG8_BAR;
            PG8_LDA(At, 0, 1); PG8_STAGE(PG8_SA(0, 0), a2, voffA);
            PG8_BAR; PG8_WAIT_L(0); PG8_MMA(1, 0, At, B0); PG8_BAR; PG8_SCHED;
            PG8_STAGE(PG8_SB(0, 1), b2 + hstep, voffB);
            PG8_WAIT_V(6); PG8_BAR; PG8_MMA(1, 1, At, B1); PG8_BAR;
            PG8_LDB(B0, 1, 0); PG8_SCHED; PG8_LDA(At, 1, 0); PG8_STAGE(PG8_SA(0, 1), a2 + hstep, voffA);
            PG8_WAIT_L(8); PG8_BAR; PG8_WAIT_L(0); PG8_MMA(0, 0, At, B0); PG8_BAR; PG8_SCHED;
            PG8_LDB(B1, 1, 1); PG8_STAGE(PG8_SB(1, 0), b3, voffB);
            PG8_BAR; PG8_WAIT_L(0); PG8_MMA(0, 1, At, B1); PG8_BAR;
            PG8_LDA(At, 1, 1); PG8_STAGE(PG8_SA(1, 0), a3, voffA);
            PG8_BAR; PG8_WAIT_L(0); PG8_MMA(1, 0, At, B0); PG8_BAR; PG8_SCHED;
            PG8_STAGE(PG8_SB(1, 1), b3 + hstep, voffB);
            PG8_WAIT_V(6); PG8_BAR; PG8_MMA(1, 1, At, B1); PG8_BAR;
        }
        PG8_STAMP();
        if constexpr (!Epi::AFTER_DRAIN) { E(acc, cur, wr, wc, fr, fq); S.done(cur); }
        PG8_STAMP();
        if (!has_next) break;
#pragma unroll
        for (int a = 0; a < 2; ++a)
#pragma unroll
            for (int b = 0; b < 2; ++b)
#pragma unroll
                for (int m = 0; m < 4; ++m)
#pragma unroll
                    for (int n = 0; n < 2; ++n) acc[a][b][m][n] = (f32x4){0.f, 0.f, 0.f, 0.f};
        cur = nxt; cA = nA; cB = nB; ++ui;
    }
    PG8_WAIT_V(0);
    if (wr == 0) PG8_BAR;
    PG8_BAR;
    if constexpr (Epi::AFTER_DRAIN) { E.fused(acc, cur, wr, wc, fr, fq, lds, wid, lane); S.done(cur); }
    PG8_STAMP();
    if (STAMP && wid == 0) { stamps[lane] = lane < nts ? (((unsigned long long)(unsigned)ts_hi << 32) | (unsigned)ts_lo) : 0ull;
        if (lane == 62) stamps[62] = rt_entry; if (lane == 63) stamps[63] = (unsigned long long)wall_clock64(); }
#undef PG8_STAMP
#undef PG8_SA
#undef PG8_SB
#undef PG8_STAGE
#undef PG8_LDA
#undef PG8_LDB
#undef PG8_MMA
#undef PG8_WAIT_V
#undef PG8_WAIT_L
#undef PG8_BAR
#undef PG8_SCHED
}
}

#define LAS __attribute__((address_space(3)))
using pg8::bf16_t; using pg8::bf16x8; using pg8::f32x4; using pg8::u32x4; using pg8::Unit; using pg8::BM; using pg8::HALF;
typedef unsigned u32x2 __attribute__((ext_vector_type(2)));

#ifndef MK_COOP
#define MK_COOP 1
#endif
#ifndef MK_ONLY
#define MK_ONLY -1
#endif
#define EN(kk) (MK_ONLY < 0 || MK_ONLY == (kk))

constexpr int M_TOK = 16384, DM = 1024, SEQ = 2048, INW = 7168, DFF = 4096, DEPTH = 4;
constexpr float ALPHA = 1.6817928305074292f;
constexpr float LN_EPS = 1e-5f;
constexpr int LDS_BYTES = 147456;
constexpr int NPHASE = 1 + 9 * DEPTH;

constexpr size_t WT_IN = 0, WT_PA = 7340032, WT_PB = 7864320, WT_PC = 8126464, WT_PD = 8388608, WT_O = 8650752, WT_M1 = 9699328, WT_M2 = 13893632, WT_END = 18087936;
constexpr size_t OFF_WT = 0;
constexpr size_t OFF_ROPE = WT_END * 2;
constexpr size_t OFF_KPART = OFF_ROPE + 524288;
constexpr size_t OFF_XN = OFF_KPART + 524288;
constexpr size_t OFF_Z = OFF_XN + 33554432;
constexpr size_t OFF_QR = OFF_Z + 234881024;
constexpr size_t OFF_KR = OFF_QR + 16777216;
constexpr size_t OFF_VT = OFF_KR + 16777216;
constexpr size_t OFF_YA = OFF_VT + 16777216;
constexpr size_t OFF_YB = OFF_YA + 16777216;
constexpr size_t OFF_YC = OFF_YB + 8388608;
constexpr size_t OFF_YD = OFF_YC + 8388608;
constexpr size_t OFF_X1 = OFF_YD + 8388608;
constexpr size_t OFF_BAR = OFF_X1 + 67108864;
constexpr size_t WS_END = OFF_BAR + 16384;
constexpr size_t OFF_H = OFF_Z;
constexpr size_t OFF_MIX = OFF_QR;

struct Params { const float* in[21]; float* out; unsigned char* ws; int ph_lo, ph_hi; };

__device__ __forceinline__ float bf_lo(unsigned w) { return __uint_as_float(w << 16); }
__device__ __forceinline__ float bf_hi(unsigned w) { return __uint_as_float(w & 0xffff0000u); }
__device__ __forceinline__ unsigned pk(float lo, float hi) { return pg8::cvt_pk_bf16(lo, hi); }
__device__ __forceinline__ float sigm(float x) { return __builtin_amdgcn_rcpf(1.0f + __builtin_amdgcn_exp2f(-1.4426950408889634f * x)); }
__device__ __forceinline__ float wsum(float v) { v += __shfl_xor(v, 1); v += __shfl_xor(v, 2); v += __shfl_xor(v, 4); v += __shfl_xor(v, 8); v += __shfl_xor(v, 16); v += __shfl_xor(v, 32); return v; }

struct EpiRelu2 {
    static constexpr bool PERM = true, AFTER_DRAIN = false;
    bf16_t* O; int ldc;
    __device__ __forceinline__ void operator()(const f32x4 (&acc)[2][2][4][2], const Unit& u, int wr, int wc, int fr, int fq) const {
        const int row0 = u.pm * BM + wr * 64 + fr, col0 = u.pn * BM + wc * 32 + 8 * fq;
#pragma unroll
        for (int ai = 0; ai < 2; ++ai)
#pragma unroll
            for (int m = 0; m < 4; ++m) { bf16_t* rowp = O + (size_t)(row0 + ai * HALF + m * 16) * ldc + col0;
#pragma unroll
                for (int bj = 0; bj < 2; ++bj) { f32x4 v0 = acc[ai][bj][m][0], v1 = acc[ai][bj][m][1];
#pragma unroll
                    for (int j = 0; j < 4; ++j) { const float a = fmaxf(v0[j], 0.f), b = fmaxf(v1[j], 0.f); v0[j] = a * a; v1[j] = b * b; }
                    u32x4 w; w.x = pk(v0[0], v0[1]); w.y = pk(v0[2], v0[3]); w.z = pk(v1[0], v1[1]); w.w = pk(v1[2], v1[3]);
                    *(u32x4*)(rowp + bj * HALF) = w; } }
    }
};
struct EpiGate {
    static constexpr bool PERM = true, AFTER_DRAIN = false;
    const bf16_t* G; bf16_t* MIX; int FIRST;
    __device__ __forceinline__ void operator()(const f32x4 (&acc)[2][2][4][2], const Unit& u, int wr, int wc, int fr, int fq) const {
        const int row0 = u.pm * BM + wr * 64 + fr, col0 = u.pn * BM + wc * 32 + 8 * fq;
        const unsigned goff0 = ((unsigned)row0 * INW + col0) * 2u, moff0 = ((unsigned)row0 * DM + col0) * 2u;
        const char* Gb = (const char*)G; char* Mb = (char*)MIX;
#pragma unroll
        for (int ai = 0; ai < 2; ++ai)
#pragma unroll
            for (int m = 0; m < 4; ++m) {
#pragma unroll
                for (int bj = 0; bj < 2; ++bj) {
                    const unsigned goff = goff0 + (unsigned)((ai * HALF + m * 16) * INW + bj * HALF) * 2u, moff = moff0 + (unsigned)((ai * HALF + m * 16) * DM + bj * HALF) * 2u;
                    const u32x4 gl = *(const u32x4*)(Gb + goff);
                    u32x4 old = {0u, 0u, 0u, 0u}; if (!FIRST) old = *(const u32x4*)(Mb + moff);
                    const f32x4 v0 = acc[ai][bj][m][0], v1 = acc[ai][bj][m][1];
                    float o0 = sigm(bf_lo(gl.x)) * v0[0], o1 = sigm(bf_hi(gl.x)) * v0[1], o2 = sigm(bf_lo(gl.y)) * v0[2], o3 = sigm(bf_hi(gl.y)) * v0[3];
                    float o4 = sigm(bf_lo(gl.z)) * v1[0], o5 = sigm(bf_hi(gl.z)) * v1[1], o6 = sigm(bf_lo(gl.w)) * v1[2], o7 = sigm(bf_hi(gl.w)) * v1[3];
                    { o0 += bf_lo(old.x); o1 += bf_hi(old.x); o2 += bf_lo(old.y); o3 += bf_hi(old.y); o4 += bf_lo(old.z); o5 += bf_hi(old.z); o6 += bf_lo(old.w); o7 += bf_hi(old.w); }
                    u32x4 w; w.x = pk(o0, o1); w.y = pk(o2, o3); w.z = pk(o4, o5); w.w = pk(o6, o7);
                    *(u32x4*)(Mb + moff) = w; }
                asm volatile("" ::: "memory"); }
    }
};
struct EpiRes {
    static constexpr bool PERM = false, AFTER_DRAIN = false;
    const float* base; float* out;
    __device__ __forceinline__ void operator()(const f32x4 (&acc)[2][2][4][2], const Unit& u, int wr, int wc, int fr, int fq) const {
        const int row0 = u.pm * BM + wr * 64 + fr, col0 = u.pn * BM + wc * 32 + 4 * fq;
#pragma unroll
        for (int ai = 0; ai < 2; ++ai)
#pragma unroll
            for (int m = 0; m < 4; ++m) { const size_t off = (size_t)(row0 + ai * HALF + m * 16) * DM + col0;
#pragma unroll
                for (int bj = 0; bj < 2; ++bj)
#pragma unroll
                    for (int n = 0; n < 2; ++n) { const size_t o = off + bj * HALF + n * 16; const f32x4 b = *(const f32x4*)(base + o); *(f32x4*)(out + o) = b * ALPHA + acc[ai][bj][m][n]; } }
    }
};

__device__ __forceinline__ void convert_layer(const Params& p, int l, LAS unsigned char* lds, const int tid, const int bid) {
    bf16_t* WT = (bf16_t*)(p.ws + OFF_WT);
    LAS float* tile = (LAS float*)lds;
    for (int t = bid; t < 4416; t += gridDim.x) {
        const float* src; int K, N, tt; size_t dst;
        if (t < 1792)      { src = p.in[1]  + (size_t)l * 1024 * 7168; K = 1024; N = 7168; dst = WT_IN; tt = t; }
        else if (t < 1920) { src = p.in[10] + (size_t)l * 512 * 1024;  K = 512;  N = 1024; dst = WT_PA; tt = t - 1792; }
        else if (t < 1984) { src = p.in[11] + (size_t)l * 256 * 1024;  K = 256;  N = 1024; dst = WT_PB; tt = t - 1920; }
        else if (t < 2048) { src = p.in[12] + (size_t)l * 256 * 1024;  K = 256;  N = 1024; dst = WT_PC; tt = t - 1984; }
        else if (t < 2112) { src = p.in[13] + (size_t)l * 256 * 1024;  K = 256;  N = 1024; dst = WT_PD; tt = t - 2048; }
        else if (t < 2368) { src = p.in[14] + (size_t)l * 1024 * 1024; K = 1024; N = 1024; dst = WT_O;  tt = t - 2112; }
        else if (t < 3392) { src = p.in[17] + (size_t)l * 1024 * 4096; K = 1024; N = 4096; dst = WT_M1; tt = t - 2368; }
        else               { src = p.in[18] + (size_t)l * 4096 * 1024; K = 4096; N = 1024; dst = WT_M2; tt = t - 3392; }
        const int ntn = N >> 6, k0 = (tt / ntn) * 64, n0 = (tt % ntn) * 64;
#pragma unroll
        for (int i = 0; i < 8; ++i) { const int k = (tid >> 6) + 8 * i; tile[k * 65 + (tid & 63)] = src[(size_t)(k0 + k) * N + n0 + (tid & 63)]; }
        __syncthreads();
        { const int n = tid >> 3, kc = tid & 7; float v[8];
#pragma unroll
          for (int j = 0; j < 8; ++j) v[j] = tile[(kc * 8 + j) * 65 + n];
          u32x4 w; w.x = pk(v[0], v[1]); w.y = pk(v[2], v[3]); w.z = pk(v[4], v[5]); w.w = pk(v[6], v[7]);
          *(u32x4*)(WT + dst + (size_t)(n0 + n) * K + k0 + kc * 8) = w; }
        __syncthreads();
    }
}

__device__ __forceinline__ void phase0(const Params& p, LAS unsigned char* lds, const int tid, const int bid) {
    const size_t gtid = (size_t)bid * 512 + tid, gsz = (size_t)gridDim.x * 512;
    float2* rope = (float2*)(p.ws + OFF_ROPE);
    { const int i0 = tid & 31;
        float inv = 1.0f;
        inv = (i0 == 1) ? 7.498942018e-01f : inv;
        inv = (i0 == 2) ? 5.623413324e-01f : inv;
        inv = (i0 == 3) ? 4.216965139e-01f : inv;
        inv = (i0 == 4) ? 3.162277639e-01f : inv;
        inv = (i0 == 5) ? 2.371373773e-01f : inv;
        inv = (i0 == 6) ? 1.778279394e-01f : inv;
        inv = (i0 == 7) ? 1.333521456e-01f : inv;
        inv = (i0 == 8) ? 1.000000015e-01f : inv;
        inv = (i0 == 9) ? 7.498942316e-02f : inv;
        inv = (i0 == 10) ? 5.623413250e-02f : inv;
        inv = (i0 == 11) ? 4.216964915e-02f : inv;
        inv = (i0 == 12) ? 3.162277490e-02f : inv;
        inv = (i0 == 13) ? 2.371373773e-02f : inv;
        inv = (i0 == 14) ? 1.778279431e-02f : inv;
        inv = (i0 == 15) ? 1.333521400e-02f : inv;
        inv = (i0 == 16) ? 9.999999776e-03f : inv;
        inv = (i0 == 17) ? 7.498942316e-03f : inv;
        inv = (i0 == 18) ? 5.623413250e-03f : inv;
        inv = (i0 == 19) ? 4.216964822e-03f : inv;
        inv = (i0 == 20) ? 3.162277630e-03f : inv;
        inv = (i0 == 21) ? 2.371373819e-03f : inv;
        inv = (i0 == 22) ? 1.778279431e-03f : inv;
        inv = (i0 == 23) ? 1.333521446e-03f : inv;
        inv = (i0 == 24) ? 1.000000047e-03f : inv;
        inv = (i0 == 25) ? 7.498941850e-04f : inv;
        inv = (i0 == 26) ? 5.623413017e-04f : inv;
        inv = (i0 == 27) ? 4.216965172e-04f : inv;
        inv = (i0 == 28) ? 3.162277571e-04f : inv;
        inv = (i0 == 29) ? 2.371373703e-04f : inv;
        inv = (i0 == 30) ? 1.778279402e-04f : inv;
        inv = (i0 == 31) ? 1.333521504e-04f : inv;

        for (size_t idx = gtid; idx < 65536; idx += gsz) { const int t = (int)(idx >> 5);
            const float ang = (float)t * inv;
            float rev = ang * 0.15915494309189535f; rev -= floorf(rev);
            const float ang_hi = rev;
            rope[idx] = make_float2(__builtin_amdgcn_cosf(ang_hi), __builtin_amdgcn_sinf(ang_hi)); } }
    const float4* x4 = (const float4*)p.in[0]; u32x4* xn = (u32x4*)(p.ws + OFF_XN);
    for (size_t idx = gtid; idx < (size_t)M_TOK * DM / 8; idx += gsz) { const float4 a = x4[2 * idx], b = x4[2 * idx + 1];
        u32x4 w; w.x = pk(a.x, a.y); w.y = pk(a.z, a.w); w.z = pk(b.x, b.y); w.w = pk(b.z, b.w); xn[idx] = w; }
    convert_layer(p, 0, lds, tid, bid);
}

__device__ __forceinline__ void ln_phase(float* X, const float* gam, const float* bet, bf16_t* XN, const int tid, const int bid) {
    const int lane = tid & 63, wave = tid >> 6;
    f32x4 g[4], b[4];
#pragma unroll
    for (int i = 0; i < 4; ++i) { g[i] = *(const f32x4*)(gam + lane * 4 + 256 * i); b[i] = *(const f32x4*)(bet + lane * 4 + 256 * i); }
    for (int r = bid * 8 + wave; r < M_TOK; r += gridDim.x * 8) {
        float* xr = X + (size_t)r * DM + lane * 4; f32x4 v[4]; float s = 0.f;
#pragma unroll
        for (int i = 0; i < 4; ++i) { v[i] = *(const f32x4*)(xr + 256 * i); s += (v[i][0] + v[i][1]) + (v[i][2] + v[i][3]); }
        const float mu = wsum(s) * (1.0f / 1024.0f); float q = 0.f;
#pragma unroll
        for (int i = 0; i < 4; ++i) { v[i] = v[i] - mu; q += (v[i][0] * v[i][0] + v[i][1] * v[i][1]) + (v[i][2] * v[i][2] + v[i][3] * v[i][3]); }
        const float rstd = 1.0f / sqrtf(wsum(q) * (1.0f / 1024.0f) + LN_EPS);
#pragma unroll
        for (int i = 0; i < 4; ++i) { const f32x4 y = v[i] * rstd * g[i] + b[i]; *(f32x4*)(xr + 256 * i) = y;
            u32x2 w; w.x = pk(y[0], y[1]); w.y = pk(y[2], y[3]); *(u32x2*)(XN + (size_t)r * DM + lane * 4 + 256 * i) = w; }
    }
}

__device__ __forceinline__ void mixers_phase(const Params& p, int l, LAS unsigned char* lds, const int tid, const int bid) {
    const int lane = tid & 63, wave = tid >> 6;
    const bf16_t* Z = (const bf16_t*)(p.ws + OFF_Z);
    const float* rope = (const float*)(p.ws + OFF_ROPE);
    bf16_t* QR = (bf16_t*)(p.ws + OFF_QR); bf16_t* KR = (bf16_t*)(p.ws + OFF_KR); bf16_t* VT = (bf16_t*)(p.ws + OFF_VT);
    float* kpart = (float*)(p.ws + OFF_KPART);
    bf16_t* YB = (bf16_t*)(p.ws + OFF_YB); bf16_t* YC = (bf16_t*)(p.ws + OFF_YC); bf16_t* YD = (bf16_t*)(p.ws + OFF_YD);
    for (int tile = bid; tile < 256; tile += gridDim.x) {
        const int b = tile >> 5, t0 = (tile & 31) * 64, row0 = tile * 64;
        {
            const int cgp = tid & 63, qk = cgp >> 5, head = (cgp >> 2) & 7, dch = cgp & 3, tg = tid >> 6;
            float ks[16];
#pragma unroll
            for (int e = 0; e < 16; ++e) ks[e] = 0.f;
            bf16_t* dstb = (qk ? KR : QR) + ((size_t)(b * 8 + head) * SEQ) * 64 + dch * 8;
#pragma unroll 2
            for (int i = 0; i < 8; ++i) { const int tl = tg * 8 + i, t = t0 + tl;
                const bf16_t* src = Z + (size_t)(row0 + tl) * INW + qk * 512 + head * 64 + dch * 8;
                const u32x4 lo = *(const u32x4*)src, hi = *(const u32x4*)(src + 32);
                const f32x4* cs = (const f32x4*)(rope + ((size_t)t * 32 + dch * 8) * 2);
                const f32x4 c0 = cs[0], c1 = cs[1], c2 = cs[2], c3 = cs[3];
                float x1[8] = {bf_lo(lo.x), bf_hi(lo.x), bf_lo(lo.y), bf_hi(lo.y), bf_lo(lo.z), bf_hi(lo.z), bf_lo(lo.w), bf_hi(lo.w)};
                float x2[8] = {bf_lo(hi.x), bf_hi(hi.x), bf_lo(hi.y), bf_hi(hi.y), bf_lo(hi.z), bf_hi(hi.z), bf_lo(hi.w), bf_hi(hi.w)};
                float cc[8] = {c0[0], c0[2], c1[0], c1[2], c2[0], c2[2], c3[0], c3[2]};
                float ss[8] = {c0[1], c0[3], c1[1], c1[3], c2[1], c2[3], c3[1], c3[3]};
                float o1[8], o2[8];
#pragma unroll
                for (int e = 0; e < 8; ++e) { o1[e] = x1[e] * cc[e] - x2[e] * ss[e]; o2[e] = x2[e] * cc[e] + x1[e] * ss[e]; ks[e] += o1[e]; ks[8 + e] += o2[e]; }
                u32x4 w1, w2; w1.x = pk(o1[0], o1[1]); w1.y = pk(o1[2], o1[3]); w1.z = pk(o1[4], o1[5]); w1.w = pk(o1[6], o1[7]);
                w2.x = pk(o2[0], o2[1]); w2.y = pk(o2[2], o2[3]); w2.z = pk(o2[4], o2[5]); w2.w = pk(o2[6], o2[7]);
                bf16_t* d = dstb + (size_t)t * 64; *(u32x4*)d = w1; *(u32x4*)(d + 32) = w2; }
            LAS float* red = (LAS float*)lds;
            if (qk) {
#pragma unroll
                for (int e = 0; e < 8; ++e) { red[tg * 512 + head * 64 + dch * 8 + e] = ks[e]; red[tg * 512 + head * 64 + 32 + dch * 8 + e] = ks[8 + e]; } }
        }
        {
            LAS unsigned char* vst = lds + 16384;
#pragma unroll
            for (int i = 0; i < 8; ++i) { const int idx = tid + 512 * i, r = idx >> 6, ch = idx & 63;
                *(LAS u32x4*)(vst + r * 1024 + ch * 16) = *(const u32x4*)(Z + (size_t)(row0 + r) * INW + 1024 + ch * 8); }
        }
        {
            const float* wsc = p.in[9] + (size_t)l * 3 * 256;
#pragma unroll 1
            for (int i = 0; i < 4; ++i) { const int idx = tid + 512 * i, tl = idx >> 5, c0 = (idx & 31) * 8, t = t0 + tl;
                float acc[8];
#pragma unroll
                for (int e = 0; e < 8; ++e) acc[e] = 0.f;
#pragma unroll
                for (int j = 0; j < 3; ++j) { if (t - 2 + j >= 0) { const bf16_t* zr = Z + (size_t)(row0 + tl - 2 + j) * INW;
                    const u32x4 xx = *(const u32x4*)(zr + 2304 + c0), cv = *(const u32x4*)(zr + 2816 + c0);
                    const f32x4 wa = *(const f32x4*)(wsc + j * 256 + c0), wb = *(const f32x4*)(wsc + j * 256 + c0 + 4);
                    acc[0] += wa[0] * (bf_lo(xx.x) * bf_lo(cv.x)); acc[1] += wa[1] * (bf_hi(xx.x) * bf_hi(cv.x));
                    acc[2] += wa[2] * (bf_lo(xx.y) * bf_lo(cv.y)); acc[3] += wa[3] * (bf_hi(xx.y) * bf_hi(cv.y));
                    acc[4] += wb[0] * (bf_lo(xx.z) * bf_lo(cv.z)); acc[5] += wb[1] * (bf_hi(xx.z) * bf_hi(cv.z));
                    acc[6] += wb[2] * (bf_lo(xx.w) * bf_lo(cv.w)); acc[7] += wb[3] * (bf_hi(xx.w) * bf_hi(cv.w)); } }
                const u32x4 bb = *(const u32x4*)(Z + (size_t)(row0 + tl) * INW + 2560 + c0);
                u32x4 w; w.x = pk(bf_lo(bb.x) * acc[0], bf_hi(bb.x) * acc[1]); w.y = pk(bf_lo(bb.y) * acc[2], bf_hi(bb.y) * acc[3]);
                w.z = pk(bf_lo(bb.z) * acc[4], bf_hi(bb.z) * acc[5]); w.w = pk(bf_lo(bb.w) * acc[6], bf_hi(bb.w) * acc[7]);
                *(u32x4*)(YD + (size_t)(row0 + tl) * 256 + c0) = w; }
        }
        __syncthreads();
        {
            LAS float* red = (LAS float*)lds; float s = 0.f;
#pragma unroll
            for (int g8 = 0; g8 < 8; ++g8) s += red[g8 * 512 + tid];
            kpart[(size_t)tile * 512 + tid] = s;
            LAS unsigned short* vst = (LAS unsigned short*)(lds + 16384);
            const int h = tid >> 6, d = tid & 63;
            bf16_t* dst = VT + ((size_t)((b * 8 + h) * 64 + d)) * SEQ + t0;
#pragma unroll
            for (int g8 = 0; g8 < 8; ++g8) { unsigned e[8];
#pragma unroll
                for (int j = 0; j < 8; ++j) e[j] = vst[(g8 * 8 + j) * 512 + tid];
                u32x4 w; w.x = e[0] | (e[1] << 16); w.y = e[2] | (e[3] << 16); w.z = e[4] | (e[5] << 16); w.w = e[6] | (e[7] << 16);
                *(u32x4*)(dst + g8 * 8) = w; }
        }
        __syncthreads();
        {
            LAS float* U = (LAS float*)lds;
            for (int idx = tid; idx < 94 * 32; idx += 512) { const int r = idx >> 5, c0 = (idx & 31) * 8, tl = r - 30;
                f32x4 u0 = {0.f, 0.f, 0.f, 0.f}, u1 = {0.f, 0.f, 0.f, 0.f};
                if (t0 + tl >= 0) { const bf16_t* zr = Z + (size_t)(row0 + tl) * INW;
                    const u32x4 a = *(const u32x4*)(zr + 1536 + c0), g = *(const u32x4*)(zr + 1792 + c0);
                    u0[0] = bf_lo(a.x) * sigm(bf_lo(g.x)); u0[1] = bf_hi(a.x) * sigm(bf_hi(g.x)); u0[2] = bf_lo(a.y) * sigm(bf_lo(g.y)); u0[3] = bf_hi(a.y) * sigm(bf_hi(g.y));
                    u1[0] = bf_lo(a.z) * sigm(bf_lo(g.z)); u1[1] = bf_hi(a.z) * sigm(bf_hi(g.z)); u1[2] = bf_lo(a.w) * sigm(bf_lo(g.w)); u1[3] = bf_hi(a.w) * sigm(bf_hi(g.w)); }
                *(LAS f32x4*)(U + r * 256 + c0) = u0; *(LAS f32x4*)(U + r * 256 + c0 + 4) = u1; }
            __syncthreads();
            const int c = tid & 255, grp = tid >> 8;
            const float* wdw = p.in[3] + (size_t)l * 31 * 256 + c;
            float w[31];
#pragma unroll
            for (int j = 0; j < 31; ++j) w[j] = wdw[j * 256];
            const float bias = p.in[4][l * 256 + c];
            float cv[32];
#pragma unroll
            for (int o = 0; o < 32; ++o) cv[o] = bias;
#pragma unroll
            for (int r = 0; r < 62; ++r) { const float uv = U[(grp * 32 + r) * 256 + c];
#pragma unroll
                for (int o = 0; o < 32; ++o) { if (r - o >= 0 && r - o <= 30) cv[o] += w[r - o] * uv; } }
            __syncthreads();
#pragma unroll
            for (int o = 0; o < 32; ++o) U[(grp * 32 + o) * 256 + c] = cv[o];
            __syncthreads();
            const f32x4 g4 = *(const f32x4*)(p.in[5] + l * 256 + lane * 4), b4 = *(const f32x4*)(p.in[6] + l * 256 + lane * 4);
#pragma unroll 2
            for (int i = 0; i < 8; ++i) { const int tl = wave * 8 + i;
                f32x4 v = *(LAS f32x4*)(U + tl * 256 + lane * 4);
                const float mu = wsum((v[0] + v[1]) + (v[2] + v[3])) * (1.0f / 256.0f);
                v = v - mu;
                const float rstd = 1.0f / sqrtf(wsum((v[0] * v[0] + v[1] * v[1]) + (v[2] * v[2] + v[3] * v[3])) * (1.0f / 256.0f) + LN_EPS);
                f32x4 y = v * rstd * g4 + b4;
#pragma unroll
                for (int e = 0; e < 4; ++e) y[e] = y[e] * sigm(y[e]);
                u32x2 wv; wv.x = pk(y[0], y[1]); wv.y = pk(y[2], y[3]);
                *(u32x2*)(YB + (size_t)(row0 + tl) * 256 + lane * 4) = wv; }
            __syncthreads();
        }
        {
            LAS float* D = (LAS float*)lds;
            LAS float* WL = (LAS float*)(lds + 65536);
            const float* wp = p.in[7] + (size_t)l * 16384;
#pragma unroll
            for (int i = 0; i < 8; ++i) { const int idx = tid + 512 * i; *(LAS f32x4*)(WL + idx * 4) = *(const f32x4*)(wp + idx * 4); }
            const int c = tid & 255, grp = tid >> 8, gi = c >> 6, W = 2 << gi;
            const unsigned short* zc = (const unsigned short*)Z + (size_t)row0 * INW + 2048 + c;
            const int ts = grp * 32;
            float sum = 0.f;
            for (int k = 1; k < W; ++k) { if (t0 + ts - k >= 0) sum += __uint_as_float((unsigned)zc[(ptrdiff_t)(ts - k) * INW] << 16); }
            for (int o = 0; o < 32; ++o) { const int tl = ts + o, t = t0 + tl;
                const float un = __uint_as_float((unsigned)zc[(ptrdiff_t)tl * INW] << 16);
                sum += un;
                const int cnt = (t + 1 < W) ? (t + 1) : W;
                D[tl * 256 + c] = sum / (float)cnt - un;
                if (t - W + 1 >= 0) sum -= __uint_as_float((unsigned)zc[(ptrdiff_t)(tl - W + 1) * INW] << 16); }
            __syncthreads();
            const int dd = c & 63;
            float acc[32];
#pragma unroll
            for (int o = 0; o < 32; ++o) acc[o] = 0.f;
#pragma unroll 1
            for (int c4 = 0; c4 < 16; ++c4) {
                const float w0 = WL[(gi * 64 + c4 * 4 + 0) * 64 + dd], w1 = WL[(gi * 64 + c4 * 4 + 1) * 64 + dd], w2 = WL[(gi * 64 + c4 * 4 + 2) * 64 + dd], w3 = WL[(gi * 64 + c4 * 4 + 3) * 64 + dd];
#pragma unroll
                for (int o = 0; o < 32; ++o) { const f32x4 dv = *(LAS f32x4*)(D + (ts + o) * 256 + gi * 64 + c4 * 4);
                    acc[o] += (dv[0] * w0 + dv[1] * w1) + (dv[2] * w2 + dv[3] * w3); } }
            const float scl = p.in[8][l * 256 + c];
            unsigned short* yc = (unsigned short*)YC + (size_t)(row0 + ts) * 256 + c;
#pragma unroll
            for (int o = 0; o < 32; ++o) yc[o * 256] = (unsigned short)(pk(acc[o] * scl, 0.f) & 0xffffu);
            __syncthreads();
        }
    }
}

__device__ __forceinline__ void attn_phase(const Params& p, LAS unsigned char* lds, const int tid, const int bid) {
    const int lane = tid & 63, wave = tid >> 6, m = lane & 15, g = lane >> 4;
    const bf16_t* QR = (const bf16_t*)(p.ws + OFF_QR); const bf16_t* KR = (const bf16_t*)(p.ws + OFF_KR); const bf16_t* VT = (const bf16_t*)(p.ws + OFF_VT);
    const float* kpart = (const float*)(p.ws + OFF_KPART);
    bf16_t* YA = (bf16_t*)(p.ws + OFF_YA);
    constexpr int KBUF = 32768, VBUF = 64 * 528, BUF = KBUF + VBUF;
    LAS float* kbl = (LAS float*)(lds + 2 * BUF);
    const float NEG = -__builtin_huge_valf();
    const float SC = 0.125f * 1.4426950408889634f;
    int koff[2][2];
#pragma unroll
    for (int T = 0; T < 2; ++T) { const int kl = 8 * (m >> 2) + (m & 3) + 4 * T, f = (kl & 3) | ((kl >> 1) & 4);
#pragma unroll
        for (int kk = 0; kk < 2; ++kk) koff[T][kk] = kl * 128 + (((4 * kk + g) ^ f) * 16); }
    const int voff = m * 528 + g * 16;
    for (int s = bid; s < 256; s += gridDim.x) {
        const int bh = s >> 2, kq = s & 3, b = bh >> 3, h = bh & 7;
#pragma unroll 1
        for (int ii = 0; ii < 4; ++ii) {
            const int hb = (ii == 0) ? 15 - kq : (ii == 1) ? 8 + kq : (ii == 2) ? 7 - kq : kq;
            const int j = hb >> 1, half = hb & 1;
            const int qpos = half * 128 + wave * 16 + m;
            const size_t qrow = (size_t)bh * SEQ + j * 256 + qpos;
            const bf16x8 qf0 = *(const bf16x8*)(QR + qrow * 64 + 8 * g), qf1 = *(const bf16x8*)(QR + qrow * 64 + 32 + 8 * g);
            { const int n = tid >> 6, d = tid & 63;
              if (n < j) { const float* kp = kpart + (size_t)(b * 32 + n * 4) * 512 + h * 64 + d; kbl[n * 64 + d] = ((kp[0] + kp[512]) + (kp[1024] + kp[1536])) * (1.0f / 256.0f); } }
            const bf16_t* kbase = KR + (size_t)bh * SEQ * 64;
            const bf16_t* vbase = VT + (size_t)bh * 64 * SEQ;
            u32x4 kreg[4], vreg[4];
#pragma unroll
            for (int i = 0; i < 4; ++i) { const int idx = tid + 512 * i;
                kreg[i] = *(const u32x4*)(kbase + (size_t)j * 16384 + idx * 8);
                vreg[i] = *(const u32x4*)(vbase + (size_t)(idx >> 5) * SEQ + j * 256 + (idx & 31) * 8); }
#pragma unroll
            for (int i = 0; i < 4; ++i) { const int idx = tid + 512 * i, key = idx >> 3, ch = idx & 7, f = (key & 3) | ((key >> 1) & 4);
                *(LAS u32x4*)(lds + key * 128 + ((ch ^ f) * 16)) = kreg[i];
                *(LAS u32x4*)(lds + KBUF + (idx >> 5) * 528 + (idx & 31) * 16) = vreg[i]; }
            __syncthreads();
            unsigned selmask;
            if (j <= 3) selmask = (1u << j) - 1u;
            else {
                float qv[16];
                { const u32x4 a = __builtin_bit_cast(u32x4, qf0), c2 = __builtin_bit_cast(u32x4, qf1);
                  qv[0] = bf_lo(a.x); qv[1] = bf_hi(a.x); qv[2] = bf_lo(a.y); qv[3] = bf_hi(a.y); qv[4] = bf_lo(a.z); qv[5] = bf_hi(a.z); qv[6] = bf_lo(a.w); qv[7] = bf_hi(a.w);
                  qv[8] = bf_lo(c2.x); qv[9] = bf_hi(c2.x); qv[10] = bf_lo(c2.y); qv[11] = bf_hi(c2.y); qv[12] = bf_lo(c2.z); qv[13] = bf_hi(c2.z); qv[14] = bf_lo(c2.w); qv[15] = bf_hi(c2.w); }
                float sc[7];
#pragma unroll
                for (int n = 0; n < 7; ++n) { float part = 0.f;
                    if (n < j) {
#pragma unroll
                        for (int e = 0; e < 8; ++e) part += qv[e] * kbl[n * 64 + 8 * g + e] + qv[8 + e] * kbl[n * 64 + 32 + 8 * g + e];
                        part += __shfl_xor(part, 16); part += __shfl_xor(part, 32); }
                    sc[n] = (n < j) ? part : NEG; }
                selmask = 0u;
#pragma unroll
                for (int r = 0; r < 3; ++r) { float best = NEG; unsigned bi = 0u;
#pragma unroll
                    for (int n = 0; n < 7; ++n) { const bool take = (((selmask >> n) & 1u) == 0u) && (sc[n] > best); best = take ? sc[n] : best; bi = take ? (unsigned)n : bi; }
                    selmask |= 1u << bi; }
            }
            f32x4 O[4];
#pragma unroll
            for (int dt = 0; dt < 4; ++dt) O[dt] = (f32x4){0.f, 0.f, 0.f, 0.f};
            float m_run = NEG, l_run = 0.f;
#pragma unroll 1
            for (int it = 0; it <= j; ++it) {
                const int blk = (it == 0) ? j : it - 1;
                const bool more = (it + 1 <= j);
                if (more) {
#pragma unroll
                    for (int i = 0; i < 4; ++i) { const int idx = tid + 512 * i;
                        kreg[i] = *(const u32x4*)(kbase + (size_t)it * 16384 + idx * 8);
                        vreg[i] = *(const u32x4*)(vbase + (size_t)(idx >> 5) * SEQ + it * 256 + (idx & 31) * 8); } }
                const bool own = (it == 0);
                const bool sel = own || (((selmask >> blk) & 1u) != 0u);
                int nch;
                if (own) nch = ((half * 128 + wave * 16 + 15) >> 5) + 1; else nch = (__ballot(sel) != 0ull) ? 8 : 0;
                LAS unsigned char* kb_l = lds + (it & 1) * BUF; LAS unsigned char* vb_l = kb_l + KBUF;
#pragma unroll 1
                for (int c = 0; c < nch; ++c) {
                    f32x4 S0 = {0.f, 0.f, 0.f, 0.f}, S1 = {0.f, 0.f, 0.f, 0.f};
                    { const bf16x8 k00 = *(LAS const bf16x8*)(kb_l + c * 4096 + koff[0][0]), k01 = *(LAS const bf16x8*)(kb_l + c * 4096 + koff[0][1]);
                      const bf16x8 k10 = *(LAS const bf16x8*)(kb_l + c * 4096 + koff[1][0]), k11 = *(LAS const bf16x8*)(kb_l + c * 4096 + koff[1][1]);
                      S0 = __builtin_amdgcn_mfma_f32_16x16x32_bf16(k00, qf0, S0, 0, 0, 0); S0 = __builtin_amdgcn_mfma_f32_16x16x32_bf16(k01, qf1, S0, 0, 0, 0);
                      S1 = __builtin_amdgcn_mfma_f32_16x16x32_bf16(k10, qf0, S1, 0, 0, 0); S1 = __builtin_amdgcn_mfma_f32_16x16x32_bf16(k11, qf1, S1, 0, 0, 0); }
                    float sv[8];
#pragma unroll
                    for (int r = 0; r < 4; ++r) { sv[r] = S0[r] * SC; sv[4 + r] = S1[r] * SC; }
                    if (own) { const int kp0 = c * 32 + 8 * g;
#pragma unroll
                        for (int e = 0; e < 8; ++e) sv[e] = (kp0 + e <= qpos) ? sv[e] : NEG; }
                    else if (!sel) {
#pragma unroll
                        for (int e = 0; e < 8; ++e) sv[e] = NEG; }
                    float mx = fmaxf(fmaxf(fmaxf(sv[0], sv[1]), fmaxf(sv[2], sv[3])), fmaxf(fmaxf(sv[4], sv[5]), fmaxf(sv[6], sv[7])));
                    mx = fmaxf(mx, __shfl_xor(mx, 16)); mx = fmaxf(mx, __shfl_xor(mx, 32));
                    const float mn = fmaxf(m_run, mx);
                    const float al = __builtin_amdgcn_exp2f(m_run - mn);
                    float ps = 0.f;
#pragma unroll
                    for (int e = 0; e < 8; ++e) { sv[e] = __builtin_amdgcn_exp2f(sv[e] - mn); ps += sv[e]; }
                    l_run = l_run * al + ps; m_run = mn;
                    u32x4 pw; pw.x = pk(sv[0], sv[1]); pw.y = pk(sv[2], sv[3]); pw.z = pk(sv[4], sv[5]); pw.w = pk(sv[6], sv[7]);
                    const bf16x8 pf = __builtin_bit_cast(bf16x8, pw);
#pragma unroll
                    for (int dt = 0; dt < 4; ++dt) { const bf16x8 vf = *(LAS const bf16x8*)(vb_l + dt * (16 * 528) + voff + c * 64);
                        O[dt] = O[dt] * al; O[dt] = __builtin_amdgcn_mfma_f32_16x16x32_bf16(vf, pf, O[dt], 0, 0, 0); }
                }
                if (more) { LAS unsigned char* nb_l = lds + ((it + 1) & 1) * BUF;
#pragma unroll
                    for (int i = 0; i < 4; ++i) { const int idx = tid + 512 * i, key = idx >> 3, ch = idx & 7, f = (key & 3) | ((key >> 1) & 4);
                        *(LAS u32x4*)(nb_l + key * 128 + ((ch ^ f) * 16)) = kreg[i];
                        *(LAS u32x4*)(nb_l + KBUF + (idx >> 5) * 528 + (idx & 31) * 16) = vreg[i]; } }
                __syncthreads();
            }
            float lt = l_run; lt += __shfl_xor(lt, 16); lt += __shfl_xor(lt, 32);
            const float inv = 1.0f / lt;
            bf16_t* yo = YA + ((size_t)b * SEQ + j * 256 + qpos) * 512 + h * 64 + 4 * g;
#pragma unroll
            for (int dt = 0; dt < 4; ++dt) { u32x2 w; w.x = pk(O[dt][0] * inv, O[dt][1] * inv); w.y = pk(O[dt][2] * inv, O[dt][3] * inv); *(u32x2*)(yo + 16 * dt) = w; }
        }
    }
}


#define XB_TMO      128
#define XB_XCNT(j)  (256  + 64 * (j))
#define XB_XSUB(j)  (1280 + 64 * (j))
#define XB_XGEN(j)  (2304 + 64 * (j))
#define XB_TOP      3328
#define XB_TOPGEN   3392
#define XCD_BAR_WORDS 3456
#define XB_SPIN_CAP (1u << 20)
__device__ __forceinline__ unsigned xb_ld(unsigned* p)              { return __hip_atomic_load(p, __ATOMIC_RELAXED, __HIP_MEMORY_SCOPE_AGENT); }
__device__ __forceinline__ unsigned xb_add(unsigned* p, unsigned v) { return __hip_atomic_fetch_add(p, v, __ATOMIC_RELAXED, __HIP_MEMORY_SCOPE_AGENT); }
__device__ __forceinline__ unsigned xb_xcc_id() { return (unsigned)__builtin_amdgcn_s_getreg((3 << 11) | 20) & 0xFu; }
#define XB_SPIN(cond, bar) do { unsigned _sp = 0; while (cond) { __builtin_amdgcn_s_sleep(1); \
    if ((++_sp & 255u) == 0u) { if (xb_ld(&(bar)[XB_TMO])) break; if (_sp > XB_SPIN_CAP) { atomicAdd(&(bar)[XB_TMO], 1u); break; } } } } while (0)
__device__ __forceinline__ void xcd_barrier_complete(unsigned* bar, unsigned x, unsigned& nloc, unsigned& nx) {
    const unsigned G = gridDim.x;
    unsigned sum, cnt, mine, sp = 0u;
    for (;;) {
        sum = 0u; cnt = 0u; mine = 0u;
#pragma unroll
        for (unsigned j = 0; j < 16; ++j) { const unsigned c = xb_ld(&bar[XB_XCNT(j)]); sum += c; cnt += (c > 0u) ? 1u : 0u; mine = (j == x) ? c : mine; }
        if (sum == G) break;
        __builtin_amdgcn_s_sleep(1);
        if ((++sp & 255u) == 0u) { if (xb_ld(&bar[XB_TMO])) break; if (sp > XB_SPIN_CAP) { atomicAdd(&bar[XB_TMO], 1u); break; } }
    }
    nloc = mine > 0u ? mine : 1u; nx = cnt > 0u ? cnt : 1u;
}
__device__ __forceinline__ void xcd_barrier(unsigned* bar, volatile LAS unsigned* st, const int tid) {
    asm volatile("s_waitcnt vmcnt(0)" ::: "memory");
    __syncthreads();
    if (tid == 0) {
        const unsigned x = xb_xcc_id();
        __builtin_amdgcn_s_waitcnt(0);
        unsigned nloc = st[0], nx = st[1];
        if (nloc == 0u) { xcd_barrier_complete(bar, x, nloc, nx); st[0] = nloc; st[1] = nx; }
        const unsigned old = xb_add(&bar[XB_XSUB(x)], 1u);
        const unsigned gen = old / nloc;
        if (old + 1u == (gen + 1u) * nloc) {
            __builtin_amdgcn_fence(__ATOMIC_RELEASE, "agent");
            asm volatile("s_waitcnt vmcnt(0)" ::: "memory");
            const unsigned og = xb_add(&bar[XB_TOP], 1u);
            const unsigned tg = og / nx;
            if (og + 1u == (tg + 1u) * nx) xb_add(&bar[XB_TOPGEN], 1u);
            else XB_SPIN(xb_ld(&bar[XB_TOPGEN]) == tg, bar);
            __builtin_amdgcn_fence(__ATOMIC_ACQUIRE, "agent");
            xb_add(&bar[XB_XGEN(x)], 1u);
            asm volatile("s_waitcnt vmcnt(0)" ::: "memory");
        } else {
            XB_SPIN(xb_ld(&bar[XB_XGEN(x)]) == gen, bar);
            __builtin_amdgcn_fence(__ATOMIC_ACQUIRE, "agent");
            asm volatile("s_waitcnt vmcnt(0)" ::: "memory");
        }
    }
    __syncthreads();
}

__global__ void __launch_bounds__(512, 2) mega_fwd(Params p_arg) {
    extern __shared__ __attribute__((aligned(16))) unsigned char smem[];
    LAS unsigned char* lds = (LAS unsigned char*)smem;
    const int ph_lo = p_arg.ph_lo, ph_hi = p_arg.ph_hi;
    const int wave_s = __builtin_amdgcn_readfirstlane((int)threadIdx.x >> 6);
    volatile LAS unsigned* bst = (volatile LAS unsigned*)(lds + LDS_BYTES - 16);
    if (threadIdx.x == 0) { bst[0] = 0u; bst[1] = 0u; (void)xb_add(&((unsigned*)(p_arg.ws + OFF_BAR))[XB_XCNT(xb_xcc_id())], 1u); }
    __syncthreads();
#ifndef MK_DUP
#define MK_DUP 0
#endif
#pragma unroll 1
    for (int step = 2 * ph_lo; step < 2 * ph_hi; ++step) {
        const int ph = step >> 1;
        if ((step & 1) && !(ph > 0 && ((MK_DUP >> ((ph - 1) % 9)) & 1))) continue;
        typedef const __attribute__((address_space(4))) Params* CParamsPtr;
        CParamsPtr pp = (CParamsPtr)__builtin_amdgcn_kernarg_segment_ptr(); asm volatile("" : "+s"(pp));
        Params p;
#pragma unroll
        for (int i = 0; i < 21; ++i) p.in[i] = pp->in[i];
        p.out = pp->out; p.ws = pp->ws; p.ph_lo = 0; p.ph_hi = 0;
        unsigned zr = 0u; asm volatile("" : "+v"(zr)); int tid = wave_s * 64 + (int)__builtin_amdgcn_mbcnt_hi(~0u, __builtin_amdgcn_mbcnt_lo(~0u, zr));
        int bid = blockIdx.x; asm volatile("" : "+s"(bid));
        bf16_t* WT = (bf16_t*)(p.ws + OFF_WT);
        bf16_t* XN = (bf16_t*)(p.ws + OFF_XN); bf16_t* Z = (bf16_t*)(p.ws + OFF_Z); bf16_t* H = (bf16_t*)(p.ws + OFF_H); bf16_t* MIX = (bf16_t*)(p.ws + OFF_MIX);
        float* X1 = (float*)(p.ws + OFF_X1);
        if (ph == 0) { if (EN(9)) phase0(p, lds, tid, bid); }
        else {
            const int l = (ph - 1) / 9, k = (ph - 1) % 9;
            if (k == 0 && EN(0)) {
                pg8::Gemm gm{XN, WT + WT_IN, M_TOK, INW, DM}; pg8::StaticOrder S; S.init(M_TOK, INW, (int)gridDim.x, bid);
                pg8::EpiBf16<0> E{Z, INW, p.in[2] + (size_t)l * INW, 0, 0};
                pg8::gemm_phase<pg8::EpiBf16<0>, pg8::StaticOrder, false>(lds, gm, S, E, nullptr, tid);
            } else if (k == 1 && EN(1)) mixers_phase(p, l, lds, tid, bid);
            else if (k == 2 && EN(2)) attn_phase(p, lds, tid, bid);
            else if (k == 3 && EN(3)) {
#pragma unroll 1
                for (int br = 0; br < 4; ++br) {
                    unsigned zr2 = 0u; asm volatile("" : "+v"(zr2)); int tid2 = wave_s * 64 + (int)__builtin_amdgcn_mbcnt_hi(~0u, __builtin_amdgcn_mbcnt_lo(~0u, zr2));
                    int bid2 = blockIdx.x; asm volatile("" : "+s"(bid2));
                    pg8::StaticOrder S; S.init(M_TOK, DM, (int)gridDim.x, bid2);
                    pg8::Gemm gm{(const bf16_t*)(p.ws + (br == 0 ? OFF_YA : OFF_YB + (size_t)(br - 1) * 8388608)), WT + (br == 0 ? WT_PA : WT_PB + (size_t)(br - 1) * 262144), M_TOK, DM, br == 0 ? 512 : 256};
                    EpiGate E{Z + 3072 + br * 1024, MIX, br == 0 ? 1 : 0}; pg8::gemm_phase<EpiGate, pg8::StaticOrder, false>(lds, gm, S, E, nullptr, tid2); }
            } else if ((k == 4 || k == 7) && EN(4)) {
                pg8::Gemm gm{k == 4 ? MIX : H, WT + (k == 4 ? WT_O : WT_M2), M_TOK, DM, k == 4 ? DM : DFF}; pg8::StaticOrder S; S.init(M_TOK, DM, (int)gridDim.x, bid);
                EpiRes E{k == 4 ? (l == 0 ? p.in[0] : (const float*)p.out) : (const float*)X1, k == 4 ? X1 : p.out}; pg8::gemm_phase<EpiRes, pg8::StaticOrder, false>(lds, gm, S, E, nullptr, tid);
            } else if (k == 5 && EN(5)) ln_phase(X1, p.in[15] + l * DM, p.in[16] + l * DM, XN, tid, bid);
            else if (k == 6 && EN(6)) {
                pg8::Gemm gm{XN, WT + WT_M1, M_TOK, DFF, DM}; pg8::StaticOrder S; S.init(M_TOK, DFF, (int)gridDim.x, bid);
                EpiRelu2 E{H, DFF}; pg8::gemm_phase<EpiRelu2, pg8::StaticOrder, false>(lds, gm, S, E, nullptr, tid);
            } else if (k == 8 && EN(8)) {
                ln_phase(p.out, p.in[19] + l * DM, p.in[20] + l * DM, XN, tid, bid);
                if (l + 1 < DEPTH) convert_layer(p, l + 1, lds, tid, bid);
            }
        }
        if (step + 1 < 2 * ph_hi) {
            if (ph == 0) { __syncthreads(); cg::this_grid().sync(); }
            else xcd_barrier((unsigned*)(p.ws + OFF_BAR), bst, tid);
        }
    }
}

extern "C" void kernel_launch(void* const* d_in, const int* in_sizes, int n_in, void* d_out, int out_size, void* d_ws, size_t ws_size, hipStream_t stream) {
    static int grid = 0;
    if (grid == 0) {
        if (n_in != 21 || ws_size < WS_END) { fprintf(stderr, "kernel_launch: unexpected n_in %d or ws_size %zu (< %zu)\n", n_in, ws_size, (size_t)WS_END); grid = -1; return; }
        if (hipFuncSetAttribute((const void*)mega_fwd, hipFuncAttributeMaxDynamicSharedMemorySize, LDS_BYTES) != hipSuccess) { fprintf(stderr, "kernel_launch: hipFuncSetAttribute failed\n"); grid = -1; return; }
        int dev = 0, cus = 0, per_cu = 0;
        (void)hipGetDevice(&dev); (void)hipDeviceGetAttribute(&cus, hipDeviceAttributeMultiprocessorCount, dev);
        (void)hipOccupancyMaxActiveBlocksPerMultiprocessor(&per_cu, (const void*)mega_fwd, 512, LDS_BYTES);
        if (per_cu < 1) { fprintf(stderr, "kernel_launch: occupancy query says %d blocks per CU\n", per_cu); per_cu = 1; }
        (void)hipGetLastError();
        grid = cus * 1;
        if (grid > 256) grid = 256;
    }
    if (grid < 0) return;
    Params p{};
    for (int i = 0; i < 21; ++i) p.in[i] = (const float*)d_in[i];
    p.out = (float*)d_out; p.ws = (unsigned char*)d_ws;
    (void)hipMemsetAsync((unsigned char*)d_ws + OFF_BAR, 0, 16384, stream);
#if MK_COOP
    p.ph_lo = 0; p.ph_hi = NPHASE;
    void* args[] = {&p};
    hipError_t e = hipLaunchCooperativeKernel((const void*)mega_fwd, dim3(grid), dim3(512), args, LDS_BYTES, stream);
    if (e != hipSuccess) fprintf(stderr, "cooperative launch failed: %s (grid %d)\n", hipGetErrorString(e), grid);
#else
    for (int ph = 0; ph < NPHASE; ++ph) { p.ph_lo = ph; p.ph_hi = ph + 1; hipLaunchKernelGGL(mega_fwd, dim3(grid), dim3(512), LDS_BYTES, stream, p); }
#endif
}
```
